# Optimizing an MI355X kernel written in HIP

```python
import math
import jax, jax.numpy as jnp
from jax import lax
import numpy as np

D_MODEL = 1024
BATCH = 2
SEQ = 16384
DEPTH = 4

N_EVEN = (DEPTH + 1) // 2
N_ODD = DEPTH // 2
D_FF = 4 * D_MODEL
EPS = 1e-6
NEG = -1e30
FORCE = 1e9
HEAD_DIM = 64

SSD_HEADS = 8
SSD_INNER = SSD_HEADS * HEAD_DIM
SSD_GROUPS = 2
SSD_RPG = SSD_HEADS // SSD_GROUPS
SSD_STATE = 128
SSD_CONV = 4
SSD_CHUNK = 128
SSD_CONV_DIM = SSD_INNER + 2 * SSD_GROUPS * SSD_STATE
SSD_IN = SSD_INNER + SSD_CONV_DIM + SSD_HEADS
DT_MIN = 0.001
DT_MAX = 0.1

NSA_HEADS = 8
NSA_KV = 2
NSA_RPG = NSA_HEADS // NSA_KV
NSA_CMP_LEN = 32
NSA_CMP_STRIDE = 16
NSA_SLC_LEN = 64
NSA_TOPK = 16
NSA_WIN = 512
NSA_CMP_HIDDEN = 256
NSA_QBLK = 128
NSA_Q = NSA_HEADS * HEAD_DIM
NSA_KVW = NSA_KV * HEAD_DIM
NSA_IN = NSA_Q + 6 * NSA_KVW + 3 * NSA_HEADS

EVEN_IN = SSD_IN + NSA_IN
EVEN_MIX = SSD_INNER + NSA_Q

SWA_HEADS = 8
SWA_KV = 2
SWA_RPG = SWA_HEADS // SWA_KV
SWA_WIN = 128
SWA_QBLK = 128
SWA_Q = SWA_HEADS * HEAD_DIM
SWA_KVW = SWA_KV * HEAD_DIM
SWA_IN = SWA_Q + 2 * SWA_KVW

S5_CH = 512
S5_GROUP_CH = 16
S5_GROUPS = S5_CH // S5_GROUP_CH
S5_STATE = 64

ODD_IN = SWA_IN + S5_CH
ODD_MIX = SWA_Q + S5_CH

kernel_name = 'hybrid_ssd_nsa_swa_s5_trunk'


def _rmsnorm(x, g):
    xf = x.astype(jnp.float32)
    y = xf * lax.rsqrt(jnp.mean(xf * xf, axis=-1, keepdims=True) + EPS)
    return (y * g.astype(jnp.float32)).astype(x.dtype)


def _masked_softmax(s, mask):
    s = jnp.where(mask, s.astype(jnp.float32), NEG)
    p = jax.nn.softmax(s, axis=-1)
    return jnp.where(mask, p, 0.0)


def _causal_depthwise_conv(x, w, b):
    k, c = w.shape
    y = lax.conv_general_dilated(x, w.astype(x.dtype)[:, None, :], window_strides=(1,),
                                 padding=[(k - 1, 0)], dimension_numbers=('NWC', 'WIO', 'NWC'),
                                 feature_group_count=c)
    return y + b.astype(y.dtype)


def _ssd_chunked_scan(xs, dt, a, bm, cm):
    bsz, seq, g, r, p = xs.shape
    n = bm.shape[-1]
    t = SSD_CHUNK
    nc = seq // t
    dt = dt.reshape(bsz, nc, t, g, r)
    a_cum = jnp.cumsum(dt * a, axis=2)
    xd = xs.astype(jnp.float32).reshape(bsz, nc, t, g, r, p) * dt[..., None]
    bc = bm.astype(jnp.float32).reshape(bsz, nc, t, g, n)
    cc = cm.astype(jnp.float32).reshape(bsz, nc, t, g, n)
    causal = jnp.tril(jnp.ones((t, t), dtype=bool))[:, :, None, None]
    seg = a_cum[:, :, :, None] - a_cum[:, :, None, :]
    decay = jnp.exp(jnp.where(causal, seg, NEG))
    cb = jnp.einsum('bctgn,bcsgn->bctsg', cc, bc)
    y_diag = jnp.einsum('bctsg,bctsgr,bcsgrp->bctgrp', cb, decay, xd)
    decay_to_end = jnp.exp(a_cum[:, :, -1:] - a_cum)
    states = jnp.einsum('bctgn,bctgr,bctgrp->bcgrpn', bc, decay_to_end, xd)
    chunk_decay = jnp.exp(a_cum[:, :, -1])

    def carry_state(h, inp):
        s_c, d_c = inp
        return h * d_c[..., None, None] + s_c, h

    h0 = jnp.zeros((bsz, g, r, p, n), jnp.float32)
    _, h_in = lax.scan(carry_state, h0, (jnp.moveaxis(states, 1, 0), jnp.moveaxis(chunk_decay, 1, 0)))
    h_in = jnp.moveaxis(h_in, 0, 1)
    y_off = jnp.einsum('bctgn,bcgrpn,bctgr->bctgrp', cc, h_in, jnp.exp(a_cum))
    return (y_diag + y_off).reshape(bsz, seq, g, r, p)


def _ssd_mixer(u, conv_w, conv_b, dt_bias, a_log, d_skip, norm_g):
    bsz, seq, _ = u.shape
    gn = SSD_GROUPS * SSD_STATE
    z = u[..., :SSD_INNER]
    xbc = u[..., SSD_INNER:SSD_INNER + SSD_CONV_DIM]
    dt_raw = u[..., SSD_INNER + SSD_CONV_DIM:]
    xbc = jax.nn.silu(_causal_depthwise_conv(xbc, conv_w, conv_b))
    xs = xbc[..., :SSD_INNER].reshape(bsz, seq, SSD_GROUPS, SSD_RPG, HEAD_DIM)
    bm = xbc[..., SSD_INNER:SSD_INNER + gn].reshape(bsz, seq, SSD_GROUPS, SSD_STATE)
    cm = xbc[..., SSD_INNER + gn:].reshape(bsz, seq, SSD_GROUPS, SSD_STATE)
    dt = jax.nn.softplus(dt_raw.astype(jnp.float32) + dt_bias.astype(jnp.float32))
    dt = dt.reshape(bsz, seq, SSD_GROUPS, SSD_RPG)
    a = -jnp.exp(a_log.astype(jnp.float32)).reshape(SSD_GROUPS, SSD_RPG)
    y = _ssd_chunked_scan(xs, dt, a, bm, cm)
    y = y + xs.astype(jnp.float32) * d_skip.astype(jnp.float32).reshape(SSD_GROUPS, SSD_RPG, 1)
    y = y.reshape(bsz, seq, SSD_INNER) * jax.nn.silu(z.astype(jnp.float32))
    y = _rmsnorm(y.reshape(bsz, seq, SSD_GROUPS, SSD_INNER // SSD_GROUPS),
                 norm_g.reshape(SSD_GROUPS, SSD_INNER // SSD_GROUPS))
    return y.reshape(bsz, seq, SSD_INNER).astype(u.dtype)


def _nsa_compress(kv, pe, w1, b1, w2, b2):
    bsz, seq, g, d = kv.shape
    ratio = NSA_CMP_LEN // NSA_CMP_STRIDE
    nc = seq // NSA_CMP_STRIDE - ratio + 1
    pieces = kv.reshape(bsz, seq // NSA_CMP_STRIDE, NSA_CMP_STRIDE, g, d)
    blocks = jnp.concatenate([pieces[:, j:j + nc] for j in range(ratio)], axis=2)
    blocks = blocks + pe[:, None, :]
    flat = jnp.moveaxis(blocks, 3, 2).reshape(bsz, nc, g, NSA_CMP_LEN * d)
    hid = jax.nn.gelu(flat @ w1 + b1)
    return hid @ w2 + b2


def _nsa_mixer(u, pe, w1, b1, w2, b2):
    bsz, seq, _ = u.shape
    g_, r_, d_ = NSA_KV, NSA_RPG, HEAD_DIM
    q = u[..., :NSA_Q].reshape(bsz, seq, g_, r_, d_)
    parts = [u[..., NSA_Q + i * NSA_KVW:NSA_Q + (i + 1) * NSA_KVW].reshape(bsz, seq, g_, d_) for i in range(6)]
    k_cmp, v_cmp, k_slc, v_slc, k_win, v_win = parts
    gates = jax.nn.sigmoid(u[..., NSA_Q + 6 * NSA_KVW:].astype(jnp.float32)).reshape(bsz, seq, g_, r_, 3)
    kc = _nsa_compress(k_cmp, pe[0], w1[0], b1[0], w2[0], b2[0])
    vc = _nsa_compress(v_cmp, pe[1], w1[1], b1[1], w2[1], b2[1])
    nc = kc.shape[1]
    ns = seq // NSA_SLC_LEN
    topk = min(NSA_TOPK, ns)
    cmp_end = jnp.arange(nc) * NSA_CMP_STRIDE + NSA_CMP_LEN - 1
    c_start = jnp.arange(nc)[:, None] * NSA_CMP_STRIDE
    s_start = jnp.arange(ns)[None, :] * NSA_SLC_LEN
    overlap = ((c_start < s_start + NSA_SLC_LEN) & (c_start + NSA_CMP_LEN > s_start)).astype(jnp.float32)
    ks_blocks = jnp.moveaxis(k_slc.reshape(bsz, ns, NSA_SLC_LEN, g_, d_), 3, 1)
    vs_blocks = jnp.moveaxis(v_slc.reshape(bsz, ns, NSA_SLC_LEN, g_, d_), 3, 1)
    pad = ((0, 0), (NSA_WIN, 0), (0, 0), (0, 0))
    kw_pad = jnp.pad(k_win, pad)
    vw_pad = jnp.pad(v_win, pad)
    gather = jax.vmap(jax.vmap(lambda blocks, ix: blocks[ix]))
    scale = HEAD_DIM ** -0.5
    span = NSA_WIN + NSA_QBLK
    x_sel = topk * NSA_SLC_LEN

    def query_block(qb):
        s0 = qb * NSA_QBLK
        t = s0 + jnp.arange(NSA_QBLK)
        qblk = lax.dynamic_slice_in_dim(q, s0, NSA_QBLK, axis=1)
        gblk = lax.dynamic_slice_in_dim(gates, s0, NSA_QBLK, axis=1)
        cmask = cmp_end[None, :] <= t[:, None]
        p_cmp = _masked_softmax(jnp.einsum('bqgrd,bngd->bgrqn', qblk, kc) * scale, cmask)
        o_cmp = jnp.einsum('bgrqn,bngd->bqgrd', p_cmp, vc)
        imp = jnp.einsum('bgrqn,nj->bgqj', p_cmp, overlap)
        cur = (t // NSA_SLC_LEN)[:, None]
        j = jnp.arange(ns)[None, :]
        forced = (j == 0) | (j == cur) | (j == cur - 1)
        imp = jnp.where(forced, FORCE, jnp.where(j <= cur, imp, -FORCE))
        _, idx = lax.top_k(imp, topk)
        ks = gather(ks_blocks, idx).reshape(bsz, g_, NSA_QBLK, x_sel, d_)
        vs = gather(vs_blocks, idx).reshape(bsz, g_, NSA_QBLK, x_sel, d_)
        kpos = (idx[..., None] * NSA_SLC_LEN + jnp.arange(NSA_SLC_LEN)).reshape(bsz, g_, NSA_QBLK, x_sel)
        smask = (kpos <= t[None, None, :, None])[:, :, None]
        p_slc = _masked_softmax(jnp.einsum('bqgrd,bgqxd->bgrqx', qblk, ks) * scale, smask)
        o_slc = jnp.einsum('bgrqx,bgqxd->bqgrd', p_slc, vs)
        kw = lax.dynamic_slice_in_dim(kw_pad, s0, span, axis=1)
        vw = lax.dynamic_slice_in_dim(vw_pad, s0, span, axis=1)
        kp = (s0 - NSA_WIN + jnp.arange(span))[None, :]
        wmask = (kp <= t[:, None]) & (kp > t[:, None] - NSA_WIN) & (kp >= 0)
        p_win = _masked_softmax(jnp.einsum('bqgrd,bkgd->bgrqk', qblk, kw) * scale, wmask)
        o_win = jnp.einsum('bgrqk,bkgd->bqgrd', p_win, vw)
        return gblk[..., 0:1] * o_cmp + gblk[..., 1:2] * o_slc + gblk[..., 2:3] * o_win

    out = lax.map(query_block, jnp.arange(seq // NSA_QBLK))
    return jnp.moveaxis(out, 0, 1).reshape(bsz, seq, NSA_Q).astype(u.dtype)


def _swa_sinks_mixer(u, sinks):
    bsz, seq, _ = u.shape
    g_, r_, d_, t_ = SWA_KV, SWA_RPG, HEAD_DIM, SWA_QBLK
    nb = seq // t_
    q = u[..., :SWA_Q].reshape(bsz, nb, t_, g_, r_, d_)
    k = u[..., SWA_Q:SWA_Q + SWA_KVW].reshape(bsz, nb, t_, g_, d_)
    v = u[..., SWA_Q + SWA_KVW:].reshape(bsz, nb, t_, g_, d_)

    def band(a):
        prev = jnp.concatenate([jnp.zeros_like(a[:, :1]), a[:, :-1]], axis=1)
        return jnp.concatenate([prev, a], axis=2)

    kb, vb = band(k), band(v)
    s = jnp.einsum('bnqgrd,bnkgd->bngrqk', q, kb).astype(jnp.float32) * (HEAD_DIM ** -0.5)
    qpos = jnp.arange(t_)[:, None]
    kpos = jnp.arange(2 * t_)[None, :] - t_
    in_win = (kpos <= qpos) & (kpos > qpos - SWA_WIN)
    first = jnp.arange(nb)[:, None, None] == 0
    mask = (in_win[None] & ~(first & (kpos < 0)[None]))[None, :, None, None]
    sink = sinks.astype(jnp.float32).reshape(1, 1, g_, r_, 1, 1)
    s = jnp.where(mask, s, NEG)
    m = jnp.maximum(jnp.max(s, axis=-1, keepdims=True), sink)
    e = jnp.where(mask, jnp.exp(s - m), 0.0)
    p = e / (jnp.sum(e, axis=-1, keepdims=True) + jnp.exp(sink - m))
    o = jnp.einsum('bngrqk,bnkgd->bnqgrd', p, vb)
    return o.reshape(bsz, seq, SWA_Q).astype(u.dtype)


def _s5_mixer(u, a_re, a_im, log_dt, b_re, b_im, c_re, c_im, d_skip, glu_w, glu_b):
    bsz, seq, _ = u.shape
    f32 = jnp.float32
    uf = u.astype(f32).reshape(bsz, seq, S5_GROUPS, S5_GROUP_CH)
    lam = lax.complex(a_re.astype(f32), a_im.astype(f32))
    step = jnp.exp(log_dt.astype(f32))[:, None]
    lam_bar = jnp.exp(lam * step)
    b_bar = ((lam_bar - 1.0) / lam)[..., None] * lax.complex(b_re.astype(f32), b_im.astype(f32))
    bu = jnp.einsum('gph,blgh->blgp', b_bar, uf.astype(jnp.complex64))
    a = jnp.broadcast_to(lam_bar, bu.shape)

    def combine(e1, e2):
        a1, x1 = e1
        a2, x2 = e2
        return a1 * a2, a2 * x1 + x2

    _, states = lax.associative_scan(combine, (a, bu), axis=1)
    c = lax.complex(c_re.astype(f32), c_im.astype(f32))
    y = jnp.einsum('ghp,blgp->blgh', c, states).real + d_skip.astype(f32).reshape(S5_GROUPS, S5_GROUP_CH) * uf
    y = jax.nn.gelu(y.reshape(bsz, seq, S5_CH))
    y = y * jax.nn.sigmoid(y @ glu_w.astype(f32) + glu_b.astype(f32))
    return y.astype(u.dtype)


def _sq_relu_mlp(x, w_up, w_down):
    return jnp.square(jax.nn.relu(x @ w_up)) @ w_down


def setup_inputs(seed: int = 0) -> dict:
    key = jax.random.key(seed)
    k = jax.random.split(key, 32)
    f32 = jnp.float32

    def nrm(i, shape, scale):
        return scale * jax.random.normal(k[i], shape, f32)

    def uni(i, shape, lo, hi):
        return jax.random.uniform(k[i], shape, f32, lo, hi)

    ssd_dt = jnp.exp(uni(10, (N_EVEN, SSD_HEADS), math.log(DT_MIN), math.log(DT_MAX)))
    return {
        'x': nrm(0, (BATCH, SEQ, D_MODEL), 1.0),
        'norm_mix': 1.0 + nrm(1, (DEPTH, D_MODEL), 0.02),
        'norm_mlp': 1.0 + nrm(2, (DEPTH, D_MODEL), 0.02),
        'norm_final': 1.0 + nrm(3, (D_MODEL,), 0.02),
        'mlp_w_up': nrm(4, (DEPTH, D_MODEL, D_FF), D_MODEL ** -0.5),
        'mlp_w_down': nrm(5, (DEPTH, D_FF, D_MODEL), D_FF ** -0.5),
        'ev_w_in': nrm(6, (N_EVEN, D_MODEL, EVEN_IN), D_MODEL ** -0.5),
        'ev_w_out': nrm(7, (N_EVEN, EVEN_MIX, D_MODEL), EVEN_MIX ** -0.5),
        'ssd_conv_w': nrm(8, (N_EVEN, SSD_CONV, SSD_CONV_DIM), SSD_CONV ** -0.5),
        'ssd_conv_b': nrm(9, (N_EVEN, SSD_CONV_DIM), 0.01),
        'ssd_dt_bias': ssd_dt + jnp.log(-jnp.expm1(-ssd_dt)),
        'ssd_a_log': jnp.log(uni(11, (N_EVEN, SSD_HEADS), 1.0, 16.0)),
        'ssd_d': 1.0 + nrm(12, (N_EVEN, SSD_HEADS), 0.1),
        'ssd_norm': 1.0 + nrm(13, (N_EVEN, SSD_INNER), 0.02),
        'nsa_pe': nrm(14, (N_EVEN, 2, NSA_CMP_LEN, HEAD_DIM), 0.02),
        'nsa_cmp_w1': nrm(15, (N_EVEN, 2, NSA_CMP_LEN * HEAD_DIM, NSA_CMP_HIDDEN), (NSA_CMP_LEN * HEAD_DIM) ** -0.5),
        'nsa_cmp_b1': nrm(16, (N_EVEN, 2, NSA_CMP_HIDDEN), 0.01),
        'nsa_cmp_w2': nrm(17, (N_EVEN, 2, NSA_CMP_HIDDEN, HEAD_DIM), NSA_CMP_HIDDEN ** -0.5),
        'nsa_cmp_b2': nrm(18, (N_EVEN, 2, HEAD_DIM), 0.01),
        'od_w_in': nrm(19, (N_ODD, D_MODEL, ODD_IN), D_MODEL ** -0.5),
        'od_w_out': nrm(20, (N_ODD, ODD_MIX, D_MODEL), ODD_MIX ** -0.5),
        'swa_sinks': nrm(21, (N_ODD, SWA_HEADS), 0.5),
        's5_a_re': -0.5 + nrm(22, (N_ODD, S5_GROUPS, S5_STATE), 0.005),
        's5_a_im': jnp.broadcast_to(math.pi * jnp.arange(S5_STATE, dtype=f32), (N_ODD, S5_GROUPS, S5_STATE)),
        's5_log_dt': uni(23, (N_ODD, S5_GROUPS), math.log(DT_MIN), math.log(DT_MAX)),
        's5_b_re': nrm(24, (N_ODD, S5_GROUPS, S5_STATE, S5_GROUP_CH), (2 * S5_GROUP_CH) ** -0.5),
        's5_b_im': nrm(25, (N_ODD, S5_GROUPS, S5_STATE, S5_GROUP_CH), (2 * S5_GROUP_CH) ** -0.5),
        's5_c_re': nrm(26, (N_ODD, S5_GROUPS, S5_GROUP_CH, S5_STATE), (2 * S5_STATE) ** -0.5),
        's5_c_im': nrm(27, (N_ODD, S5_GROUPS, S5_GROUP_CH, S5_STATE), (2 * S5_STATE) ** -0.5),
        's5_d': nrm(28, (N_ODD, S5_CH), 1.0),
        's5_glu_w': nrm(29, (N_ODD, S5_CH, S5_CH), S5_CH ** -0.5),
        's5_glu_b': nrm(30, (N_ODD, S5_CH), 0.01),
    }


def reference(x, norm_mix, norm_mlp, norm_final, mlp_w_up, mlp_w_down,
              ev_w_in, ev_w_out, ssd_conv_w, ssd_conv_b, ssd_dt_bias, ssd_a_log, ssd_d, ssd_norm,
              nsa_pe, nsa_cmp_w1, nsa_cmp_b1, nsa_cmp_w2, nsa_cmp_b2,
              od_w_in, od_w_out, swa_sinks, s5_a_re, s5_a_im, s5_log_dt, s5_b_re, s5_b_im,
              s5_c_re, s5_c_im, s5_d, s5_glu_w, s5_glu_b):
    h = x
    for layer in range(DEPTH):
        hn = _rmsnorm(h, norm_mix[layer])
        i = layer // 2
        if layer % 2 == 0:
            u = hn @ ev_w_in[i]
            y_a = _ssd_mixer(u[..., :SSD_IN], ssd_conv_w[i], ssd_conv_b[i], ssd_dt_bias[i],
                             ssd_a_log[i], ssd_d[i], ssd_norm[i])
            y_b = _nsa_mixer(u[..., SSD_IN:], nsa_pe[i], nsa_cmp_w1[i], nsa_cmp_b1[i],
                             nsa_cmp_w2[i], nsa_cmp_b2[i])
            y = jnp.concatenate([y_a, y_b], axis=-1) @ ev_w_out[i]
        else:
            u = hn @ od_w_in[i]
            y_c = _swa_sinks_mixer(u[..., :SWA_IN], swa_sinks[i])
            y_d = _s5_mixer(u[..., SWA_IN:], s5_a_re[i], s5_a_im[i], s5_log_dt[i], s5_b_re[i], s5_b_im[i],
                            s5_c_re[i], s5_c_im[i], s5_d[i], s5_glu_w[i], s5_glu_b[i])
            y = jnp.concatenate([y_c, y_d], axis=-1) @ od_w_out[i]
        h = h + y.astype(h.dtype)
        h = h + _sq_relu_mlp(_rmsnorm(h, norm_mlp[layer]), mlp_w_up[layer], mlp_w_down[layer]).astype(h.dtype)
    return _rmsnorm(h, norm_final)
```

```cpp
#include <hip/hip_runtime.h>
#include <hip/hip_cooperative_groups.h>
#include <cstdio>
namespace cg = cooperative_groups;

typedef unsigned short bfr;
typedef short bf16x8 __attribute__((ext_vector_type(8)));
typedef short bf16x4 __attribute__((ext_vector_type(4)));
typedef float f32x2 __attribute__((ext_vector_type(2)));
typedef float f32x4 __attribute__((ext_vector_type(4)));
typedef float f32x16 __attribute__((ext_vector_type(16)));
typedef unsigned u32x4 __attribute__((ext_vector_type(4)));
typedef unsigned u32x2 __attribute__((ext_vector_type(2)));
typedef __bf16 bfv2 __attribute__((ext_vector_type(2)));
#define DI __device__ __forceinline__
#define MFMA32(a, b, c) __builtin_amdgcn_mfma_f32_32x32x16_bf16((a), (b), (c), 0, 0, 0)
#define MFMA16(a, b, c) __builtin_amdgcn_mfma_f32_16x16x32_bf16((a), (b), (c), 0, 0, 0)

#ifndef GEMMSEL
#define GEMMSEL 0xffff
#endif
#ifndef NSAREP
#define NSAREP 0
#endif
#ifndef REPMASK
#define REPMASK 0
#endif
#ifndef PHMASK
#define PHMASK 1023
#endif
constexpr int T = 32768, L = 16384, DM = 1024;
constexpr float EPS = 1e-6f;
constexpr float NEGF = -1e30f;
constexpr float QSC = 0.125f * 1.4426950408889634f;
constexpr float LOG2E = 1.4426950408889634f;
constexpr size_t MBy = 1u << 20;
constexpr size_t OFF_WUP = 0, OFF_WDN = 32 * MBy, OFF_EVIN = 64 * MBy, OFF_EVOUT = 76 * MBy, OFF_ODIN = 80 * MBy, OFF_ODOUT = 86 * MBy,
                 OFF_GLU = 90 * MBy, OFF_W1 = 91 * MBy, OFF_W2 = 95 * MBy, OFF_ROWSS = 120 * MBy, OFF_S5PRE = 98 * MBy, OFF_B1EFF = 99 * MBy,
                 OFF_DTRAW = 100 * MBy, OFF_DTT = 101 * MBy, OFF_ACUM = 102 * MBy, OFF_CDEC = 103 * MBy, OFF_GATES = 104 * MBy,
                 OFF_NSAHID = 107 * MBy, OFF_KC = 111 * MBy, OFF_VCT = 111 * MBy + 512 * 1024, OFF_S5S = 112 * MBy, OFF_HB = 124 * MBy,
                 OFF_MIX = 188 * MBy, OFF_S = 252 * MBy, OFF_BAR = 508 * MBy, WS_NEED = 508 * MBy + 65536;
constexpr int EVIN_N = 2848, EVIN_NP = 2944;

struct TJob { const float* src; bfr* dst; const float* scale; int K, N, tile0, pad; };
struct Params {
  const float* in[32];
  float* out;
  unsigned char* ws;
  TJob jobs[26];
  int njobs, ntile_total;
};

DI unsigned pk2(float a, float b) { f32x2 v = {a, b}; return __builtin_bit_cast(unsigned, __builtin_convertvector(v, bfv2)); }
DI bfr f2bf(float a) { return (bfr)(pk2(a, 0.f) & 0xffffu); }
DI float bf2f(bfr x) { return __uint_as_float(((unsigned)x) << 16); }
DI float bflo(unsigned u) { return __uint_as_float(u << 16); }
DI float bfhi(unsigned u) { return __uint_as_float(u & 0xffff0000u); }
DI bf16x8 pack8(float a, float b, float c, float d, float e, float f, float g, float h) {
  u32x4 r = {pk2(a, b), pk2(c, d), pk2(e, f), pk2(g, h)};
  return __builtin_bit_cast(bf16x8, r);
}
DI bf16x8 ld8(const bfr* p) { return *(const bf16x8*)p; }
DI int crow(int i, int half) { return (i & 3) + 8 * (i >> 2) + 4 * half; }
DI float sigmoidf_(float x) { return 1.f / (1.f + __expf(-x)); }
DI float siluf_(float x) { return x / (1.f + __expf(-x)); }
DI float gelu_tanh(float x) {
  float z = 0.7978845608028654f * (x + 0.044715f * x * x * x);
  float t = 1.f - 2.f / (__expf(2.f * z) + 1.f);
  return 0.5f * x * (1.f + t);
}
DI int otid() { int t = threadIdx.x; asm volatile("" : "+v"(t)); return t; }
DI float ex2(float x) { return __builtin_amdgcn_exp2f(x); }
typedef unsigned u2v __attribute__((ext_vector_type(2)));
DI float swsum32(float x, float y) { const u2v r = __builtin_amdgcn_permlane32_swap(__float_as_uint(x), __float_as_uint(y), false, false); return __uint_as_float(r[0]) + __uint_as_float(r[1]); }
DI float swsum16(float x, float y) { const u2v r = __builtin_amdgcn_permlane16_swap(__float_as_uint(x), __float_as_uint(y), false, false); return __uint_as_float(r[0]) + __uint_as_float(r[1]); }
template <int CTRL> DI float dppf(float v) { return __int_as_float(__builtin_amdgcn_mov_dpp(__float_as_int(v), CTRL, 0xf, 0xf, true)); }
DI float xor1(float v) { return dppf<0xB1>(v); }
DI float xor2(float v) { return dppf<0x4E>(v); }
DI float rmir(float v) { return dppf<0x140>(v); }
DI float rhmir(float v) { return dppf<0x141>(v); }
DI float swmax32(float x) { const u2v r = __builtin_amdgcn_permlane32_swap(__float_as_uint(x), __float_as_uint(x), false, false); return fmaxf(__uint_as_float(r[0]), __uint_as_float(r[1])); }
DI float swmax16(float x) { const u2v r = __builtin_amdgcn_permlane16_swap(__float_as_uint(x), __float_as_uint(x), false, false); return fmaxf(__uint_as_float(r[0]), __uint_as_float(r[1])); }
DI float swadd32(float x) { const u2v r = __builtin_amdgcn_permlane32_swap(__float_as_uint(x), __float_as_uint(x), false, false); return __uint_as_float(r[0]) + __uint_as_float(r[1]); }
DI float swadd16(float x) { const u2v r = __builtin_amdgcn_permlane16_swap(__float_as_uint(x), __float_as_uint(x), false, false); return __uint_as_float(r[0]) + __uint_as_float(r[1]); }
DI float shx(float v, int m) { return __shfl_xor(v, m, 64); }

#define XB_TMO      128
#define XB_XCNT(j)  (256  + 64 * (j))
#define XB_XSUB(j)  (1280 + 64 * (j))
#define XB_XGEN(j)  (2304 + 64 * (j))
#define XB_TOP      3328
#define XB_TOPGEN   3392
#define XCD_BAR_WORDS 3456
#define XB_SPIN_CAP (1u << 20)
#define LAS __attribute__((address_space(3)))
DI unsigned xb_ld(unsigned* p) { return __hip_atomic_load(p, __ATOMIC_RELAXED, __HIP_MEMORY_SCOPE_AGENT); }
DI unsigned xb_add(unsigned* p, unsigned v) { return __hip_atomic_fetch_add(p, v, __ATOMIC_RELAXED, __HIP_MEMORY_SCOPE_AGENT); }
DI unsigned xb_xcc_id() { return (unsigned)__builtin_amdgcn_s_getreg((3 << 11) | 20) & 0xFu; }
#define XB_SPIN(cond, bar) do { unsigned _sp = 0; while (cond) { __builtin_amdgcn_s_sleep(1); \
    if ((++_sp & 255u) == 0u) { if (xb_ld(&(bar)[XB_TMO])) break; if (_sp > XB_SPIN_CAP) { atomicAdd(&(bar)[XB_TMO], 1u); break; } } } } while (0)
struct XcdBarrier { unsigned* bar; unsigned x; volatile LAS unsigned* st; };
DI void xcd_barrier_complete(unsigned* bar, unsigned x, unsigned& nloc, unsigned& nx) {
  const unsigned G = gridDim.x * gridDim.y * gridDim.z;
  unsigned sum, cnt, mine, sp = 0u;
  for (;;) {
    sum = 0u; cnt = 0u; mine = 0u;
#pragma unroll
    for (unsigned j = 0; j < 16; ++j) { const unsigned c = xb_ld(&bar[XB_XCNT(j)]); sum += c; cnt += (c > 0u) ? 1u : 0u; mine = (j == x) ? c : mine; }
    if (sum == G) break;
    __builtin_amdgcn_s_sleep(1);
    if ((++sp & 255u) == 0u) { if (xb_ld(&bar[XB_TMO])) break; if (sp > XB_SPIN_CAP) { atomicAdd(&bar[XB_TMO], 1u); break; } }
  }
  nloc = mine > 0u ? mine : 1u; nx = cnt > 0u ? cnt : 1u;
}
DI void xcd_barrier(const XcdBarrier& b) {
  asm volatile("s_waitcnt vmcnt(0)" ::: "memory");
  __syncthreads();
  if (threadIdx.x == 0) {
    unsigned* bar = b.bar;
    __builtin_amdgcn_s_waitcnt(0);
    unsigned nloc = b.st[0], nx = b.st[1];
    if (nloc == 0u) { xcd_barrier_complete(bar, b.x, nloc, nx); b.st[0] = nloc; b.st[1] = nx; }
    const unsigned old = xb_add(&bar[XB_XSUB(b.x)], 1u);
    const unsigned gen = old / nloc;
    if (old + 1u == (gen + 1u) * nloc) {
      __builtin_amdgcn_fence(__ATOMIC_RELEASE, "agent");
      asm volatile("s_waitcnt vmcnt(0)" ::: "memory");
      const unsigned og = xb_add(&bar[XB_TOP], 1u);
      const unsigned tg = og / nx;
      if (og + 1u == (tg + 1u) * nx) xb_add(&bar[XB_TOPGEN], 1u);
      else XB_SPIN(xb_ld(&bar[XB_TOPGEN]) == tg, bar);
      __builtin_amdgcn_fence(__ATOMIC_ACQUIRE, "agent");
      xb_add(&bar[XB_XGEN(b.x)], 1u);
      asm volatile("s_waitcnt vmcnt(0)" ::: "memory");
    } else {
      XB_SPIN(xb_ld(&bar[XB_XGEN(b.x)]) == gen, bar);
      __builtin_amdgcn_fence(__ATOMIC_ACQUIRE, "agent");
      asm volatile("s_waitcnt vmcnt(0)" ::: "memory");
    }
  }
  __syncthreads();
}
struct XMap { int ok, xcd, loc, nloc; };

DI int vpos(int k64) { const int k = k64 & 31; return (k64 & 32) + ((k & 15) >> 2) * 8 + (k >> 4) * 4 + (k & 3); }
DI size_t kfoff(int key, int d) { return ((size_t)((key >> 4) * 2 + (d >> 5)) * 64 + ((d & 31) >> 3) * 16 + (key & 15)) * 8 + (d & 7); }
DI size_t vfoff(int key, int d) { return ((size_t)((key >> 5) * 4 + (d >> 4)) * 64 + ((key & 15) >> 2) * 16 + (d & 15)) * 8 + ((key >> 4) & 1) * 4 + (key & 3); }
DI u32x2 pk4(const f32x4& v) { u32x2 r = {pk2(v[0], v[1]), pk2(v[2], v[3])}; return r; }
struct EpiEvenIn {
  unsigned char* ws;
  DI void operator()(int, int t, int col, f32x4 v, float rs) const {
    if (col >= EVIN_N) return;
    bfr* zb = (bfr*)(ws + OFF_S + 64 * MBy); bfr* xraw = (bfr*)(ws + OFF_S); float* dtraw = (float*)(ws + OFF_DTRAW); bfr* qn = (bfr*)(ws + OFF_S + 96 * MBy); bfr* parts = (bfr*)(ws + OFF_S + 128 * MBy); float* gates = (float*)(ws + OFF_GATES);
    v *= rs;
    if (col < 512) *(u32x2*)(zb + (size_t)t * 512 + col) = pk4(v);
    else if (col < 1536) *(u32x2*)(xraw + (size_t)t * 1024 + col - 512) = pk4(v);
    else if (col < 1544) *(f32x4*)(dtraw + (size_t)t * 8 + col - 1536) = v;
    else if (col < 2056) *(u32x2*)(qn + (size_t)t * 512 + col - 1544) = pk4(v * QSC);
    else if (col < 2824) {
      const int w = col - 2056, part = w >> 7, g = (w >> 6) & 1, d = w & 63, b = t >> 14, tl = t & (L - 1);
      bfr* pb = parts + (size_t)part * (4u * MBy);
      if (part == 3 || part == 5) {
        bfr* q = pb + (size_t)(b * 2 + g) * L * 64 + vfoff(tl, d);
        q[0] = f2bf(v[0]); q[8] = f2bf(v[1]); q[16] = f2bf(v[2]); q[24] = f2bf(v[3]);
      } else if (part < 2) *(u32x2*)(pb + ((size_t)(b * 2 + g) * L + tl) * 64 + d) = pk4(v);
      else *(u32x2*)(pb + (size_t)(b * 2 + g) * L * 64 + kfoff(tl, d)) = pk4(v);
    } else {
      f32x4 o = {sigmoidf_(v[0]), sigmoidf_(v[1]), sigmoidf_(v[2]), sigmoidf_(v[3])};
      *(f32x4*)(gates + (size_t)t * 24 + col - 2824) = o;
    }
  }
};
struct EpiOddIn {
  unsigned char* ws;
  DI void operator()(int, int t, int col, f32x4 v, float rs) const {
    bfr* qn = (bfr*)(ws + OFF_S + 96 * MBy); bfr* ksw = (bfr*)(ws + OFF_S + 128 * MBy); bfr* vswT = (bfr*)(ws + OFF_S + 136 * MBy); float* us5 = (float*)(ws + OFF_S);
    v *= rs;
    const int b = t >> 14, tl = t & (L - 1);
    if (col < 512) *(u32x2*)(qn + (size_t)t * 512 + col) = pk4(v * QSC);
    else if (col < 640) { const int g = (col - 512) >> 6, d = col & 63; *(u32x2*)(ksw + (size_t)(b * 2 + g) * L * 64 + kfoff(tl, d)) = pk4(v); }
    else if (col < 768) {
      const int g = (col - 640) >> 6, d = col & 63;
      bfr* q = vswT + (size_t)(b * 2 + g) * L * 64 + vfoff(tl, d);
      q[0] = f2bf(v[0]); q[8] = f2bf(v[1]); q[16] = f2bf(v[2]); q[24] = f2bf(v[3]);
    } else *(f32x4*)(us5 + (size_t)t * 512 + col - 768) = v;
  }
};
struct EpiRes {
  const float* hin; float* hout; bfr* hb; float* rowss_next;
  DI void operator()(int, int t, int col, f32x4 a, float) const {
    const f32x4 v = *(const f32x4*)(hin + (size_t)t * DM + col) + a;
    *(f32x4*)(hout + (size_t)t * DM + col) = v;
    *(u32x2*)(hb + (size_t)t * DM + col) = pk4(v);
    float s = v[0] * v[0] + v[1] * v[1] + v[2] * v[2] + v[3] * v[3];
    s += shx(s, 1); s += shx(s, 2); s += shx(s, 4);
    if ((threadIdx.x & 7) == 0) {
      float* pp = rowss_next + (size_t)t * 16 + (col >> 6);
      if (col & 32) s += *pp;
      *pp = s;
    }
  }
};
struct EpiUp {
  unsigned char* ws;
  DI void operator()(int, int t, int col, f32x4 v, float rs) const {
    bfr* hid = (bfr*)(ws + OFF_S);
    v *= rs;
#pragma unroll
    for (int i = 0; i < 4; ++i) v[i] = v[i] > 0.f ? v[i] * v[i] : 0.f;
    *(u32x2*)(hid + (size_t)t * 4096 + col) = pk4(v);
  }
};
struct EpiGlu {
  unsigned char* ws; const float* bias;
  DI void operator()(int, int t, int col, f32x4 a, float) const {
    const bfr* yg = (const bfr*)(ws + OFF_S + 64 * MBy); bfr* mix = (bfr*)(ws + OFF_MIX);
    const u32x2 yv = *(const u32x2*)(yg + (size_t)t * 512 + col);
    const f32x4 bb = *(const f32x4*)(bias + col);
    f32x4 o = {bflo(yv[0]) * sigmoidf_(a[0] + bb[0]), bfhi(yv[0]) * sigmoidf_(a[1] + bb[1]), bflo(yv[1]) * sigmoidf_(a[2] + bb[2]), bfhi(yv[1]) * sigmoidf_(a[3] + bb[3])};
    *(u32x2*)(mix + (size_t)t * DM + 512 + col) = pk4(o);
  }
};
struct EpiW1 {
  unsigned char* ws; int li;
  DI void operator()(int z, int r, int col, f32x4 a, float) const {
    const float* b1eff = (const float*)(ws + OFF_B1EFF) + li * 512; bfr* hid = (bfr*)(ws + OFF_NSAHID);
    const f32x4 bb = *(const f32x4*)(b1eff + z * 256 + col);
    f32x4 o = {gelu_tanh(a[0] + bb[0]), gelu_tanh(a[1] + bb[1]), gelu_tanh(a[2] + bb[2]), gelu_tanh(a[3] + bb[3])};
    *(u32x2*)(hid + ((size_t)z * 4096 + r) * 256 + col) = pk4(o);
  }
};
struct EpiW2 {
  unsigned char* ws; const float* b2;
  DI void operator()(int z, int r, int col, f32x4 a, float) const {
    if (col >= 64) return;
    bfr* kc = (bfr*)(ws + OFF_KC); bfr* vcT = (bfr*)(ws + OFF_VCT);
    const int bg = r >> 10, n = r & 1023;
    const f32x4 bb = *(const f32x4*)(b2 + z * 64 + col);
    f32x4 v = a + bb;
    if (n == 1023) v = (f32x4){0.f, 0.f, 0.f, 0.f};
    if (z == 0) *(u32x2*)(kc + (size_t)bg * 1024 * 64 + kfoff(n, col)) = pk4(v);
    else {
      bfr* q = vcT + (size_t)bg * 1024 * 64 + vfoff(n, col);
      q[0] = f2bf(v[0]); q[8] = f2bf(v[1]); q[16] = f2bf(v[2]); q[24] = f2bf(v[3]);
    }
  }
};

struct GemmDesc {
  const bfr* A; const bfr* Bt; const float* rpart; size_t sA, sB; int lda, ldb, M, N, K, nbatch, kind;
  EpiEvenIn e0; EpiOddIn e1; EpiRes e2; EpiUp e3; EpiGlu e4; EpiW1 e5; EpiW2 e6;
};
DI void epi_dispatch(const GemmDesc& d, int z, int row, int col, const f32x4& a, float rs) {
  switch (d.kind) {
    case 0: d.e0(z, row, col, a, rs); break;
    case 1: d.e1(z, row, col, a, rs); break;
    case 2: d.e2(z, row, col, a, rs); break;
    case 3: d.e3(z, row, col, a, rs); break;
    case 4: d.e4(z, row, col, a, rs); break;
    case 5: d.e5(z, row, col, a, rs); break;
    default: d.e6(z, row, col, a, rs); break;
  }
}
constexpr int GLD = 72;
DI void gemm_phase_(const GemmDesc& d, unsigned char* smem, const XMap& xm) {
  const bfr* __restrict__ A = d.A; const bfr* __restrict__ Bt = d.Bt; const float* rpart = d.rpart;
  const int lda = d.lda, ldb = d.ldb, M = d.M, N = d.N, K = d.K, nbatch = d.nbatch; const size_t sA = d.sA, sB = d.sB;
  bfr* sAq = (bfr*)smem;
  bfr* sBq = sAq + 256 * GLD;
  const int tid = otid(), lane = tid & 63, wave = tid >> 6, wm = wave >> 1, wn = wave & 1, half = lane >> 5, l32 = lane & 31;
  const int MT = M / 256, NT = N / 128, KT = K / 64;
  const int per = MT * NT, ntile = per * nbatch;
  const bool xmap = xm.ok && (((MT * nbatch) & 63) == 0);
  const int nloc = xm.nloc, xcd = xm.xcd, loc = xm.loc, MTx = (MT * nbatch) >> 3;
  const int tstart = xmap ? loc : blockIdx.x, tstep = xmap ? nloc : gridDim.x, tend = xmap ? MTx * NT : ntile;
  const int lrow = tid >> 3, lcc = (tid & 7) * 8;
  u32x4 ra[8], rb[4];
  const bfr* Ap = A; const bfr* Bp = Bt;
  int z = 0, mt = 0, nt = 0;
#define DECODE(TILE, Z, MTv, NTv) { if (xmap) { const int grp = (TILE) / (8 * NT), rem = (TILE) - grp * 8 * NT; NTv = rem >> 3; const int mg = xcd * MTx + grp * 8 + (rem & 7); Z = mg / MT; MTv = mg - Z * MT; } \
    else { Z = (TILE) / per; const int id = (TILE) % per; const int grp = id / (16 * NT), rem = id % (16 * NT); const int gm = (MT - grp * 16) < 16 ? (MT - grp * 16) : 16; MTv = grp * 16 + rem % gm; NTv = rem / gm; } }
#define GLOADS(K0) { _Pragma("unroll") for (int i = 0; i < 8; ++i) ra[i] = *(const u32x4*)(Ap + (size_t)(32 * i) * lda + (K0)); \
                     _Pragma("unroll") for (int i = 0; i < 4; ++i) rb[i] = *(const u32x4*)(Bp + (size_t)(32 * i) * ldb + (K0)); }
  for (int tile = tstart; tile < tend; tile += tstep) {
    DECODE(tile, z, mt, nt);
    Ap = A + z * sA + (size_t)(mt * 256 + lrow) * lda + lcc;
    Bp = Bt + z * sB + (size_t)(nt * 128 + lrow) * ldb + lcc;
    GLOADS(0);
    f32x16 acc[4][2];
#pragma unroll
    for (int i = 0; i < 4; ++i)
#pragma unroll
      for (int j = 0; j < 2; ++j)
#pragma unroll
        for (int r = 0; r < 16; ++r) acc[i][j][r] = 0.f;
    for (int kt = 0; kt < KT; ++kt) {
      __syncthreads();
#pragma unroll
      for (int i = 0; i < 8; ++i) *(u32x4*)(sAq + (lrow + 32 * i) * GLD + lcc) = ra[i];
#pragma unroll
      for (int i = 0; i < 4; ++i) *(u32x4*)(sBq + (lrow + 32 * i) * GLD + lcc) = rb[i];
      __syncthreads();
      if (kt + 1 < KT) GLOADS((kt + 1) * 64);
      __builtin_amdgcn_s_setprio(3);
#pragma unroll
      for (int ks = 0; ks < 4; ++ks) {
        bf16x8 bq[2];
#pragma unroll
        for (int j = 0; j < 2; ++j) bq[j] = *(const bf16x8*)(sBq + (wn * 64 + j * 32 + l32) * GLD + ks * 16 + half * 8);
#pragma unroll
        for (int ih = 0; ih < 2; ++ih) {
          bf16x8 af[2];
#pragma unroll
          for (int i = 0; i < 2; ++i) af[i] = *(const bf16x8*)(sAq + (wm * 128 + (ih * 2 + i) * 32 + l32) * GLD + ks * 16 + half * 8);
#pragma unroll
          for (int i = 0; i < 2; ++i)
#pragma unroll
            for (int j = 0; j < 2; ++j) acc[ih * 2 + i][j] = MFMA32(af[i], bq[j], acc[ih * 2 + i][j]);
        }
      }
      __builtin_amdgcn_s_setprio(0);
    }
    const int zc = z, mtc = mt, ntc = nt;
    __syncthreads();
    float* rsl = (float*)smem + 13824;
    if (rpart) {
      {
        const float* pp = rpart + (size_t)(mtc * 256 + tid) * 16;
        float sm = 0.f;
#pragma unroll
        for (int q = 0; q < 4; ++q) { const f32x4 v = *(const f32x4*)(pp + q * 4); sm += v[0]; sm += v[1]; sm += v[2]; sm += v[3]; }
        rsl[tid] = rsqrtf(sm * (1.f / DM) + EPS);
      }
      __syncthreads();
    }
    {
      float* eb = (float*)smem + wave * 2304;
      const int er = lane >> 3, ec = (lane & 7) * 4;
#pragma unroll
      for (int ip = 0; ip < 2; ++ip)
#pragma unroll
        for (int j = 0; j < 2; ++j) {
#pragma unroll
          for (int i = 0; i < 2; ++i)
#pragma unroll
            for (int e = 0; e < 16; ++e) eb[(i * 32 + crow(e, half)) * 36 + l32] = acc[ip * 2 + i][j][e];
          __builtin_amdgcn_wave_barrier();
          const int colg = ntc * 128 + wn * 64 + j * 32 + ec, rowl = wm * 128 + ip * 64 + er, rowg = mtc * 256 + rowl;
          if (d.kind == 2) {
#pragma unroll
            for (int kb = 0; kb < 8; kb += 4) {
              f32x4 hv[4];
#pragma unroll
              for (int k = 0; k < 4; ++k) hv[k] = *(const f32x4*)(d.e2.hin + (size_t)(rowg + 8 * (kb + k)) * DM + colg);
              asm volatile("" ::: "memory"); __builtin_amdgcn_sched_barrier(0);
#pragma unroll
              for (int k = 0; k < 4; ++k) {
                const int t = rowg + 8 * (kb + k);
                const f32x4 v = *(const f32x4*)(eb + ((kb + k) * 8 + er) * 36 + ec) + hv[k];
                *(f32x4*)(d.e2.hout + (size_t)t * DM + colg) = v;
                *(u32x2*)(d.e2.hb + (size_t)t * DM + colg) = pk4(v);
                float sq = v[0] * v[0] + v[1] * v[1] + v[2] * v[2] + v[3] * v[3];
                sq += xor1(sq); sq += xor2(sq); sq += rhmir(sq);
                if ((lane & 7) == 0) {
                  float* pp = d.e2.rowss_next + (size_t)t * 16 + (colg >> 6);
                  if (colg & 32) sq += *pp;
                  *pp = sq;
                }
              }
              asm volatile("" ::: "memory");
            }
          } else {
#pragma unroll 2
            for (int k = 0; k < 8; ++k) {
              const f32x4 v = *(const f32x4*)(eb + (k * 8 + er) * 36 + ec);
              epi_dispatch(d, zc, rowg + 8 * k, colg, v, rpart ? rsl[rowl + 8 * k] : 1.f);
            }
          }
          __builtin_amdgcn_wave_barrier();
        }
    }
  }
#undef GLOADS
#undef DECODE
}

DI void prep_phase(const Params& p, unsigned char* smem) {
  const int tid = otid(), lane = tid & 63, wave = tid >> 6;
  unsigned char* ws = p.ws;
  float (*tl)[33] = (float (*)[33])smem;
  for (int tix = blockIdx.x; tix < p.ntile_total; tix += gridDim.x) {
    int j = 0;
    while (j + 1 < p.njobs && p.jobs[j + 1].tile0 <= tix) ++j;
    const TJob& jb = p.jobs[j];
    const int loc = tix - jb.tile0, ntn = jb.N / 32, kt = loc / ntn, nt = loc % ntn;
    __syncthreads();
#pragma unroll
    for (int i = 0; i < 8; ++i) {
      const int r = (tid >> 5) + 8 * i, c = tid & 31;
      float v = jb.src[(size_t)(kt * 64 + r) * jb.N + nt * 32 + c];
      if (jb.scale) v *= jb.scale[kt * 64 + r];
      tl[r][c] = v;
    }
    __syncthreads();
    {
      const int n = tid >> 3, k0 = (tid & 7) * 8;
      const bf16x8 o = pack8(tl[k0][n], tl[k0 + 1][n], tl[k0 + 2][n], tl[k0 + 3][n], tl[k0 + 4][n], tl[k0 + 5][n], tl[k0 + 6][n], tl[k0 + 7][n]);
      *(bf16x8*)(jb.dst + (size_t)(nt * 32 + n) * jb.K + kt * 64 + k0) = o;
    }
  }
  const int gtid = blockIdx.x * 256 + tid, gsz = gridDim.x * 256;
  {
    bfr* evin = (bfr*)(ws + OFF_EVIN);
    for (int i = gtid; i < 2 * 96 * 1024; i += gsz) { const int inst = i / (96 * 1024), r = i % (96 * 1024); evin[(size_t)inst * EVIN_NP * 1024 + (size_t)EVIN_N * 1024 + r] = 0; }
    bfr* w2 = (bfr*)(ws + OFF_W2);
    for (int i = gtid; i < 4 * 64 * 256; i += gsz) { const int inst = i / (64 * 256), r = i % (64 * 256); w2[(size_t)inst * 128 * 256 + 64 * 256 + r] = 0; }
  }
  {
    const float* x = p.in[0];
    bfr* hb = (bfr*)(ws + OFF_HB);
    float* rs = (float*)(ws + OFF_ROWSS);
    for (int row = blockIdx.x * 4 + wave; row < T; row += gridDim.x * 4) {
      float s = 0.f;
#pragma unroll
      for (int i = 0; i < 4; ++i) {
        const int c = (i * 64 + lane) * 4;
        const f32x4 v = *(const f32x4*)(x + (size_t)row * DM + c);
        s += v[0] * v[0] + v[1] * v[1] + v[2] * v[2] + v[3] * v[3];
        u32x2 o = {pk2(v[0], v[1]), pk2(v[2], v[3])};
        *(u32x2*)(hb + (size_t)row * DM + c) = o;
      }
      s += shx(s, 1); s += shx(s, 2); s += shx(s, 4); s += shx(s, 8); s += shx(s, 16); s += shx(s, 32);
      if (lane < 16) rs[(size_t)row * 16 + lane] = lane == 0 ? s : 0.f;
    }
  }
  for (int e = gtid; e < 2 * 32 * 64; e += gsz) {
    const int i = e >> 11, gp = e & 2047, g = gp >> 6;
    const float are = p.in[22][e], aim = p.in[23][e], step = expf(p.in[24][i * 32 + g]);
    const float mag = expf(are * step), ph = aim * step;
    const float lre = mag * cosf(ph), lim = mag * sinf(ph);
    float pre = lre, pim = lim;
    for (int k = 0; k < 6; ++k) { const float nr = pre * pre - pim * pim, ni = 2.f * pre * pim; pre = nr; pim = ni; }
    const float nre = lre - 1.f, nim = lim, den = are * are + aim * aim;
    const float fre = (nre * are + nim * aim) / den, fim = (nim * are - nre * aim) / den;
    float* pre_ = (float*)(ws + OFF_S5PRE) + (size_t)i * 131072;
    pre_[gp * 2] = lre; pre_[gp * 2 + 1] = lim;
    pre_[4096 + gp * 2] = pre; pre_[4096 + gp * 2 + 1] = pim;
    float* bb = pre_ + 8192 + (size_t)gp * 32;
    for (int h = 0; h < 16; ++h) {
      const float bre = p.in[25][(size_t)e * 16 + h], bim = p.in[26][(size_t)e * 16 + h];
      bb[h] = fre * bre - fim * bim; bb[16 + h] = fre * bim + fim * bre;
    }
  }
  for (int e = gtid; e < 16 * 1024; e += gsz) {
    const int sl = e >> 10, o = e & 1023, ikv = o >> 8, n = o & 255;
    const float* pe = p.in[14] + (size_t)ikv * 2048 + sl * 128;
    const float* w1 = p.in[15] + (size_t)ikv * 2048 * 256 + (size_t)sl * 128 * 256 + n;
    float acc = 0.f;
#pragma unroll 1
    for (int k0 = 0; k0 < 128; k0 += 8) {
      float wv[8], pv[8];
#pragma unroll
      for (int k = 0; k < 8; ++k) { wv[k] = w1[(size_t)(k0 + k) * 256]; pv[k] = pe[k0 + k]; }
#pragma unroll
      for (int k = 0; k < 8; ++k) acc += pv[k] * wv[k];
    }
    ((float*)(ws + OFF_B1EFF))[1024 + e] = acc;
  }
}

DI void ssd_conv_phase(const Params& p, int ei, unsigned char* smem) {
  unsigned char* ws = p.ws;
  const bfr* xraw = (const bfr*)(ws + OFF_S);
  bfr* bct = (bfr*)(ws + OFF_HB);
  bfr* xbT = (bfr*)(ws + OFF_S + 176 * MBy);
  const float* cw = p.in[8] + (size_t)ei * 4 * 1024;
  const float* cb = p.in[9] + (size_t)ei * 1024;
  const int tid = otid(), lane = tid & 63, wave = tid >> 6;
  bfr* tile = (bfr*)smem;
  const int nconv = 256 * 16;
  for (int item = blockIdx.x; item < nconv + 256; item += gridDim.x) {
    if (item < nconv) {
      const int bc = item >> 4, slab = item & 15, c = slab * 64 + lane, tq = wave;
      const int b = bc >> 7, chunk = bc & 127, t0l = chunk * 128 + tq * 32;
      const size_t tg0 = (size_t)b * L + t0l;
      const float w0 = cw[c], w1 = cw[1024 + c], w2 = cw[2048 + c], w3 = cw[3072 + c], bias = cb[c];
      float r0 = (t0l >= 3) ? bf2f(xraw[(tg0 - 3) * 1024 + c]) : 0.f;
      float r1 = (t0l >= 2) ? bf2f(xraw[(tg0 - 2) * 1024 + c]) : 0.f;
      float r2 = (t0l >= 1) ? bf2f(xraw[(tg0 - 1) * 1024 + c]) : 0.f;
      __syncthreads();
      for (int k = 0; k < 32; ++k) {
        const float r3 = bf2f(xraw[(tg0 + k) * 1024 + c]);
        const float y = siluf_(bias + w0 * r0 + w1 * r1 + w2 * r2 + w3 * r3);
        r0 = r1; r1 = r2; r2 = r3;
        const bfr yb = f2bf(y);
        if (slab >= 8) bct[(tg0 + k) * 512 + c - 512] = yb;
        if (slab < 12) tile[lane * 136 + tq * 32 + k] = yb;
      }
      __syncthreads();
      if (slab < 12) {
#pragma unroll
        for (int i = 0; i < 4; ++i) {
          const int cid = tid + 256 * i, row = cid >> 4, cc = cid & 15;
          *(u32x4*)(xbT + ((size_t)bc * 768 + slab * 64 + row) * 128 + cc * 8) = *(const u32x4*)(tile + row * 136 + cc * 8);
        }
      }
    } else {
      const int bc = item - nconv;
      const float* dtraw = (const float*)(ws + OFF_DTRAW);
      float* dtT = (float*)(ws + OFF_DTT);
      float* acum = (float*)(ws + OFF_ACUM);
      float* cdec = (float*)(ws + OFF_CDEC);
      for (int hh = 0; hh < 2; ++hh) {
        const int h = wave * 2 + hh;
        const float bias = p.in[10][ei * 8 + h], a = -expf(p.in[11][ei * 8 + h]);
        float d0 = dtraw[((size_t)bc * 128 + lane) * 8 + h] + bias, d1 = dtraw[((size_t)bc * 128 + 64 + lane) * 8 + h] + bias;
        d0 = d0 > 20.f ? d0 : log1pf(expf(d0)); d1 = d1 > 20.f ? d1 : log1pf(expf(d1));
        float s0 = d0 * a, s1 = d1 * a;
#pragma unroll
        for (int off = 1; off < 64; off <<= 1) {
          const float u0 = __shfl_up(s0, off, 64), u1 = __shfl_up(s1, off, 64);
          if (lane >= off) { s0 += u0; s1 += u1; }
        }
        const float tot0 = __shfl(s0, 63, 64);
        s1 += tot0;
        const size_t o = ((size_t)bc * 8 + h) * 128;
        dtT[o + lane] = d0; dtT[o + 64 + lane] = d1;
        acum[o + lane] = s0; acum[o + 64 + lane] = s1;
        if (lane == 63) cdec[bc * 8 + h] = expf(s1);
      }
    }
  }
}

DI void ssd_states_item(const Params& p, int witem, float* wl  ) {
  unsigned char* ws = p.ws;
  const bfr* xbT = (const bfr*)(ws + OFF_S + 176 * MBy);
  const float* dtT = (const float*)(ws + OFF_DTT);
  const float* acum = (const float*)(ws + OFF_ACUM);
  float* states = (float*)(ws + OFF_S);
  const int lane = otid() & 63, half = lane >> 5, l32 = lane & 31;
  const int bc = witem >> 3, head = witem & 7, g = head >> 2;
  const size_t o = ((size_t)bc * 8 + head) * 128;
  const float alast = acum[o + 127];
  wl[lane] = dtT[o + lane] * __expf(alast - acum[o + lane]);
  wl[64 + lane] = dtT[o + 64 + lane] * __expf(alast - acum[o + 64 + lane]);
  __builtin_amdgcn_wave_barrier();
  __builtin_amdgcn_s_waitcnt(0xc07f);
  const bfr* xrow = xbT + ((size_t)bc * 768 + head * 64) * 128;
  const bfr* brow = xbT + ((size_t)bc * 768 + 512 + g * 128) * 128;
  float* so = states + ((size_t)bc * 8 + head) * 8192;
#pragma unroll 1
  for (int nh = 0; nh < 2; ++nh) {
    f32x16 acc[2][2];
#pragma unroll
    for (int i = 0; i < 2; ++i)
#pragma unroll
      for (int j = 0; j < 2; ++j)
#pragma unroll
        for (int r = 0; r < 16; ++r) acc[i][j][r] = 0.f;
#pragma unroll 2
    for (int ks = 0; ks < 8; ++ks) {
      const int tb = ks * 16 + half * 8;
      const f32x4 s0 = *(const f32x4*)(wl + tb), s1 = *(const f32x4*)(wl + tb + 4);
      bf16x8 af[2], bq[2];
#pragma unroll
      for (int mt = 0; mt < 2; ++mt) {
        const u32x4 raw = *(const u32x4*)(xrow + (size_t)(mt * 32 + l32) * 128 + tb);
        af[mt] = pack8(bflo(raw[0]) * s0[0], bfhi(raw[0]) * s0[1], bflo(raw[1]) * s0[2], bfhi(raw[1]) * s0[3],
                       bflo(raw[2]) * s1[0], bfhi(raw[2]) * s1[1], bflo(raw[3]) * s1[2], bfhi(raw[3]) * s1[3]);
      }
#pragma unroll
      for (int nt = 0; nt < 2; ++nt) bq[nt] = ld8(brow + (size_t)((nh * 2 + nt) * 32 + l32) * 128 + tb);
#pragma unroll
      for (int mt = 0; mt < 2; ++mt)
#pragma unroll
        for (int nt = 0; nt < 2; ++nt) acc[mt][nt] = MFMA32(af[mt], bq[nt], acc[mt][nt]);
    }
#pragma unroll
    for (int mt = 0; mt < 2; ++mt)
#pragma unroll
      for (int nt = 0; nt < 2; ++nt)
#pragma unroll
        for (int i = 0; i < 16; ++i) so[(size_t)(mt * 32 + crow(i, half)) * 128 + (nh * 2 + nt) * 32 + l32] = acc[mt][nt][i];
  }
  __builtin_amdgcn_wave_barrier();
}

DI void ssd_carry_item(const Params& p, int bitem) {
  unsigned char* ws = p.ws;
  float* states = (float*)(ws + OFF_S);
  const float* cdec = (const float*)(ws + OFF_CDEC);
  const int e = bitem * 256 + otid();
  const int b = e >> 16, head = (e >> 13) & 7, pn = e & 8191;
  float run = 0.f;
#pragma unroll 1
  for (int c0 = 0; c0 < 128; c0 += 32) {
    float sv[32], dv[32];
#pragma unroll
    for (int k = 0; k < 32; ++k) {
      const int bc = b * 128 + c0 + k;
      sv[k] = states[((size_t)bc * 8 + head) * 8192 + pn];
      dv[k] = cdec[bc * 8 + head];
    }
    asm volatile("" ::: "memory"); __builtin_amdgcn_sched_barrier(0);
#pragma unroll
    for (int k = 0; k < 32; ++k) {
      const int bc = b * 128 + c0 + k;
      states[((size_t)bc * 8 + head) * 8192 + pn] = run;
      run = run * dv[k] + sv[k];
    }
  }
}

DI void ssd_out_phase(const Params& p, int ei, unsigned char* smem) {
  unsigned char* ws = p.ws;
  const bfr* xbT = (const bfr*)(ws + OFF_S + 176 * MBy);
  const bfr* bct = (const bfr*)(ws + OFF_HB);
  const bfr* zb = (const bfr*)(ws + OFF_S + 64 * MBy);
  const float* dtT = (const float*)(ws + OFF_DTT);
  const float* acum = (const float*)(ws + OFF_ACUM);
  const float* states = (const float*)(ws + OFF_S);
  bfr* mix = (bfr*)(ws + OFF_MIX);
  const int tid = otid(), lane = tid & 63, wave = tid >> 6, half = lane >> 5, l32 = lane & 31;
  float* wac = (float*)smem + wave * 256;
  float* ssq = (float*)smem + 1024;
  for (int item = blockIdx.x; item < 512; item += gridDim.x) {
    const int bc = item >> 1, g = item & 1, head = g * 4 + wave;
    const size_t tg0 = (size_t)bc * 128;
    const size_t o = ((size_t)bc * 8 + head) * 128;
    __syncthreads();
    wac[lane] = acum[o + lane]; wac[64 + lane] = acum[o + 64 + lane];
    wac[128 + lane] = dtT[o + lane]; wac[192 + lane] = dtT[o + 64 + lane];
    __syncthreads();
    const bfr* Cm = bct + tg0 * 512 + 256 + g * 128;
    const bfr* Bm = bct + tg0 * 512 + g * 128;
    const float* hin = states + ((size_t)bc * 8 + head) * 8192;
    const bfr* xrow = xbT + ((size_t)bc * 768 + head * 64) * 128;
    const float dsk = p.in[12][ei * 8 + head];
    const float* ng = p.in[13] + (size_t)ei * 512 + head * 64;
    const float g0 = ng[l32], g1 = ng[32 + l32];
#pragma unroll 1
    for (int tt = 0; tt < 4; ++tt) {
      f32x16 Y0, Y1;
#pragma unroll
      for (int r = 0; r < 16; ++r) { Y0[r] = 0.f; Y1[r] = 0.f; }
#pragma unroll 2
      for (int ks = 0; ks < 8; ++ks) {
        const int nb = ks * 16 + half * 8;
        const bf16x8 cf = ld8(Cm + (size_t)(tt * 32 + l32) * 512 + nb);
        const float* hp0 = hin + (size_t)l32 * 128 + nb;
        const float* hp1 = hp0 + 32 * 128;
        const f32x4 a0 = *(const f32x4*)hp0, a1 = *(const f32x4*)(hp0 + 4), b0 = *(const f32x4*)hp1, b1 = *(const f32x4*)(hp1 + 4);
        Y0 = MFMA32(cf, pack8(a0[0], a0[1], a0[2], a0[3], a1[0], a1[1], a1[2], a1[3]), Y0);
        Y1 = MFMA32(cf, pack8(b0[0], b0[1], b0[2], b0[3], b1[0], b1[1], b1[2], b1[3]), Y1);
      }
#pragma unroll
      for (int i = 0; i < 16; ++i) {
        const float e = __expf(wac[tt * 32 + crow(i, half)]);
        Y0[i] *= e; Y1[i] *= e;
      }
      const float at = wac[tt * 32 + l32];
      const int tl = tt * 32 + l32;
#pragma unroll 1
      for (int st = 0; st <= tt; ++st) {
        f32x16 X;
#pragma unroll
        for (int r = 0; r < 16; ++r) X[r] = 0.f;
#pragma unroll 2
        for (int ks = 0; ks < 8; ++ks) {
          const int nb = ks * 16 + half * 8;
          const bf16x8 bfm = ld8(Bm + (size_t)(st * 32 + l32) * 512 + nb);
          const bf16x8 cfm = ld8(Cm + (size_t)(tt * 32 + l32) * 512 + nb);
          X = MFMA32(bfm, cfm, X);
        }
#pragma unroll
        for (int i = 0; i < 16; ++i) {
          const int s_ = st * 32 + crow(i, half);
          const float f = (s_ <= tl) ? __expf(at - wac[s_]) * wac[128 + s_] : 0.f;
          X[i] *= f;
        }
#pragma unroll
        for (int k2 = 0; k2 < 2; ++k2) {
          const bf16x8 pa = pack8(X[8 * k2], X[8 * k2 + 1], X[8 * k2 + 2], X[8 * k2 + 3], X[8 * k2 + 4], X[8 * k2 + 5], X[8 * k2 + 6], X[8 * k2 + 7]);
          const bfr* xp = xrow + (size_t)l32 * 128 + st * 32 + 16 * k2 + 4 * half;
          const u32x2 lo0 = *(const u32x2*)xp, hi0 = *(const u32x2*)(xp + 8);
          const u32x2 lo1 = *(const u32x2*)(xp + 32 * 128), hi1 = *(const u32x2*)(xp + 32 * 128 + 8);
          const u32x4 xv0 = {lo0[0], lo0[1], hi0[0], hi0[1]}, xv1 = {lo1[0], lo1[1], hi1[0], hi1[1]};
          Y0 = MFMA32(pa, __builtin_bit_cast(bf16x8, xv0), Y0);
          Y1 = MFMA32(pa, __builtin_bit_cast(bf16x8, xv1), Y1);
        }
      }
#pragma unroll
      for (int q = 0; q < 4; ++q) {
        asm volatile("" ::: "memory");
        const bfr* xq = xrow + (size_t)l32 * 128 + tt * 32 + 8 * q + 4 * half;
        const u32x2 xa = *(const u32x2*)xq, xb = *(const u32x2*)(xq + 32 * 128);
        const float xs0[4] = {bflo(xa[0]), bfhi(xa[0]), bflo(xa[1]), bfhi(xa[1])};
        const float xs1[4] = {bflo(xb[0]), bfhi(xb[0]), bflo(xb[1]), bfhi(xb[1])};
#pragma unroll
        for (int j = 0; j < 4; ++j) {
          const int i = q * 4 + j;
          const int t = tt * 32 + 8 * q + 4 * half + j;
          const bfr* zp = zb + (tg0 + t) * 512 + head * 64 + l32;
          Y0[i] = (Y0[i] + dsk * xs0[j]) * siluf_(bf2f(zp[0]));
          Y1[i] = (Y1[i] + dsk * xs1[j]) * siluf_(bf2f(zp[32]));
        }
      }
#pragma unroll
      for (int i = 0; i < 16; ++i) {
        float s_ = Y0[i] * Y0[i] + Y1[i] * Y1[i];
        s_ += shx(s_, 1); s_ += shx(s_, 2); s_ += shx(s_, 4); s_ += shx(s_, 8); s_ += shx(s_, 16);
        if (l32 == 0) ssq[wave * 32 + crow(i, half)] = s_;
      }
      __syncthreads();
#pragma unroll
      for (int i = 0; i < 16; ++i) {
        const int rr = crow(i, half), t = tt * 32 + rr;
        const float tot = ssq[rr] + ssq[32 + rr] + ssq[64 + rr] + ssq[96 + rr];
        const float rs = rsqrtf(tot * (1.f / 256.f) + EPS);
        bfr* mp = mix + (tg0 + t) * DM + head * 64;
        mp[l32] = f2bf(Y0[i] * rs * g0);
        mp[32 + l32] = f2bf(Y1[i] * rs * g1);
      }
      __syncthreads();
    }
  }
}

struct AttnSt { float m, l; f32x4 o[4]; };
DI void attn_init(AttnSt& s, float m0, float l0) {
  s.m = m0; s.l = l0;
#pragma unroll
  for (int i = 0; i < 4; ++i) s.o[i] = (f32x4){0.f, 0.f, 0.f, 0.f};
}
DI void attn_scores(const bfr* Kp, int key0, const bf16x8& q0, const bf16x8& q1, int r, int quad, float* sc) {
  const bfr* kr = Kp + (size_t)key0 * 64 + (quad * 16 + r) * 8;
  const bf16x8 a00 = ld8(kr), a01 = ld8(kr + 512), a10 = ld8(kr + 1024), a11 = ld8(kr + 1536);
  f32x4 s0 = {0.f, 0.f, 0.f, 0.f}, s1 = {0.f, 0.f, 0.f, 0.f};
  s0 = MFMA16(a00, q0, s0); s0 = MFMA16(a01, q1, s0);
  s1 = MFMA16(a10, q0, s1); s1 = MFMA16(a11, q1, s1);
#pragma unroll
  for (int i = 0; i < 4; ++i) { sc[i] = s0[i]; sc[4 + i] = s1[i]; }
}
DI void attn_pv(AttnSt& s, const bfr* VTp, int key0, const bf16x8& pb, int r, int quad) {
  const bfr* vb = VTp + (size_t)key0 * 64 + (quad * 16 + r) * 8;
#pragma unroll
  for (int dt = 0; dt < 4; ++dt) s.o[dt] = MFMA16(ld8(vb + dt * 512), pb, s.o[dt]);
}
DI float attn_finish_l(const AttnSt& s) { float l = swadd16(s.l); l = swadd32(l); return l; }
DI void load_q(const bfr* qn, size_t t0, int hbase, int lane, bf16x8& q0, bf16x8& q1) {
  const int r = lane & 15, quad = lane >> 4;
  const bfr* qp = qn + (t0 + (r >> 2)) * 512 + (hbase + (r & 3)) * 64 + quad * 8;
  q0 = ld8(qp); q1 = ld8(qp + 32);
}

struct KV32 { bf16x8 k[4]; bf16x8 v[4]; };
struct UnitD { const bfr* Kp; const bfr* VTp; int key0, hi, lo; bool fast, colok; };
DI void load_kv32(KV32& r, const UnitD& d, int rr, int quad) {
  const size_t off = (size_t)d.key0 * 64 + (quad * 16 + rr) * 8;
  const bfr* kr = d.Kp + off;
  const bfr* vb = d.VTp + off;
#pragma unroll
  for (int i = 0; i < 4; ++i) { r.k[i] = ld8(kr + i * 512); r.v[i] = ld8(vb + i * 512); }
}
template <int MODE>
DI void attn_step32(AttnSt& s, const KV32& kv, const bf16x8& q0, const bf16x8& q1, const UnitD& d, int quad) {
  f32x4 s0 = {0.f, 0.f, 0.f, 0.f}, s1 = {0.f, 0.f, 0.f, 0.f};
  s0 = MFMA16(kv.k[0], q0, s0); s0 = MFMA16(kv.k[1], q1, s0);
  s1 = MFMA16(kv.k[2], q0, s1); s1 = MFMA16(kv.k[3], q1, s1);
  float sc[8];
  float lm = -3e38f;
#pragma unroll
  for (int i = 0; i < 8; ++i) {
    float v = (i < 4 ? s0[i & 3] : s1[i & 3]);
    if (MODE == 0) { const int key = d.key0 + (i >> 2) * 16 + quad * 4 + (i & 3); v = (key <= d.hi && key >= d.lo) ? v : -3e38f; }
    sc[i] = v; lm = fmaxf(lm, v);
  }
  if (MODE == 1) lm = d.colok ? lm : -3e38f;
  if (__builtin_amdgcn_ballot_w64(lm > s.m + 8.f) != 0ull) {
    float mt = swmax16(lm); mt = swmax32(mt);
    const float mn = fmaxf(s.m, mt);
    const float alpha = ex2(s.m - mn);
    s.l *= alpha; s.m = mn;
#pragma unroll
    for (int dt = 0; dt < 4; ++dt) s.o[dt] *= alpha;
  }
  const float meff = (MODE == 1) ? (d.colok ? s.m : 1e30f) : s.m;
  float ps = 0.f;
#pragma unroll
  for (int i = 0; i < 8; ++i) { sc[i] = ex2(sc[i] - meff); ps += sc[i]; }
  s.l += ps;
  const bf16x8 pb = pack8(sc[0], sc[1], sc[2], sc[3], sc[4], sc[5], sc[6], sc[7]);
#pragma unroll
  for (int dt = 0; dt < 4; ++dt) s.o[dt] = MFMA16(kv.v[dt], pb, s.o[dt]);
}
#define PIN_LOADS() do { asm volatile("" ::: "memory"); __builtin_amdgcn_sched_barrier(0); } while (0)
template <class UF>
DI void attn_stream(AttnSt& s, int n, const UF& uf, const bf16x8& q0, const bf16x8& q1, int lane) {
  const int rr = lane & 15, quad = lane >> 4;
  if (n <= 0) return;
  KV32 a, b;
  { const UnitD d = uf(0); load_kv32(a, d, rr, quad); }
  PIN_LOADS();
#pragma unroll 1
  for (int u = 0; u < n; u += 2) {
    { const UnitD dn = uf(u + 1 < n ? u + 1 : n - 1); load_kv32(b, dn, rr, quad); }
    PIN_LOADS();
    { const UnitD d = uf(u); if (d.fast) attn_step32<1>(s, a, q0, q1, d, quad); else attn_step32<0>(s, a, q0, q1, d, quad); }
    PIN_LOADS();
    { const UnitD dn = uf(u + 2 < n ? u + 2 : n - 1); load_kv32(a, dn, rr, quad); }
    PIN_LOADS();
    if (u + 1 < n) { const UnitD d = uf(u + 1); if (d.fast) attn_step32<1>(s, b, q0, q1, d, quad); else attn_step32<0>(s, b, q0, q1, d, quad); }
    PIN_LOADS();
  }
}

DI void swa_item(const Params& p, int oi, int witem) {
  unsigned char* ws = p.ws;
  const bfr* qn = (const bfr*)(ws + OFF_S + 96 * MBy);
  const bfr* ksw = (const bfr*)(ws + OFF_S + 128 * MBy);
  const bfr* vswT = (const bfr*)(ws + OFF_S + 136 * MBy);
  bfr* mix = (bfr*)(ws + OFF_MIX);
  const int lane = otid() & 63, r = lane & 15, quad = lane >> 4;
  const int bg = witem >> 12, qd = witem & 4095, b = bg >> 1, g = bg & 1, t0 = qd * 4;
  bf16x8 q0, q1;
  load_q(qn, (size_t)b * L + t0, g * 4, lane, q0, q1);
  const int tq = t0 + (r >> 2), lo = tq - 127 > 0 ? tq - 127 : 0;
  const float sink = p.in[21][oi * 8 + g * 4 + (r & 3)];
  AttnSt s;
  attn_init(s, sink * LOG2E, quad == 0 ? 1.f : 0.f);
  const bfr* Kp = ksw + (size_t)bg * L * 64;
  const bfr* VTp = vswT + (size_t)bg * 256 * 4096;
  {
    int ks = t0 - 127; ks = ks < 0 ? 0 : (ks & ~31);
    const int n = ((t0 + 3) >> 5) - (ks >> 5) + 1;
    const int lomax = t0 + 3 - 127;
    auto uf = [&](int u) { UnitD d; d.Kp = Kp; d.VTp = VTp; d.key0 = ks + 32 * u; d.hi = tq; d.lo = lo; d.fast = (d.key0 >= lomax) && (d.key0 + 31 <= t0); d.colok = true; return d; };
    attn_stream(s, n, uf, q0, q1, lane);
  }
  const float l = attn_finish_l(s), inv = 1.f / l;
  bfr* mp = mix + ((size_t)b * L + tq) * DM + (g * 4 + (r & 3)) * 64 + quad * 4;
#pragma unroll
  for (int dt = 0; dt < 4; ++dt) {
    u32x2 o = {pk2(s.o[dt][0] * inv, s.o[dt][1] * inv), pk2(s.o[dt][2] * inv, s.o[dt][3] * inv)};
    *(u32x2*)(mp + dt * 16) = o;
  }
}

DI void nsa_item(const Params& p, int witem, float* wl) {
  unsigned char* ws = p.ws;
  const bfr* qn = (const bfr*)(ws + OFF_S + 96 * MBy);
  const bfr* parts = (const bfr*)(ws + OFF_S + 128 * MBy);
  const bfr* kc = (const bfr*)(ws + OFF_KC);
  const bfr* vcT = (const bfr*)(ws + OFF_VCT);
  const float* gates = (const float*)(ws + OFF_GATES);
  bfr* mix = (bfr*)(ws + OFF_MIX);
  float* own4 = wl; float* lastp = wl + 1024; int* sel = (int*)(wl + 2048);
  const int lane = otid() & 63, r = lane & 15, quad = lane >> 4;
  const int bg = witem >> 12, qd = witem & 4095, b = bg >> 1, g = bg & 1, t0 = qd * 4;
  bf16x8 q0, q1;
  load_q(qn, (size_t)b * L + t0, g * 4, lane, q0, q1);
  const int tok = r >> 2, tq = t0 + tok;
  float* resl = wl + 2176;
  const float* gp = gates + ((size_t)b * L + tq) * 24 + g * 12 + (r & 3) * 3;
  const float g_cmp = gp[0], g_slc = gp[1], g_win = gp[2];
  for (int rp = 0; rp < ((NSAREP & 1) ? 2 : 1); ++rp) {
    const bfr* Kp = kc + (size_t)bg * 1024 * 64;
    const bfr* VTp = vcT + (size_t)bg * 16 * 4096;
    const int hi = tq >= 31 ? ((tq - 31) >> 4) : -1;
    const int tmax = t0 + 3, nmax = tmax >= 31 ? ((tmax - 31) >> 4) : -1;
    float m = NEGF, lsum = 0.f;
    for (int k0 = 0; k0 <= nmax; k0 += 32) {
      float sc[8];
      attn_scores(Kp, k0, q0, q1, r, quad, sc);
      float mt = NEGF;
#pragma unroll
      for (int i = 0; i < 8; ++i) { const int key = k0 + (i >> 2) * 16 + quad * 4 + (i & 3); sc[i] = key <= hi ? sc[i] : NEGF; mt = fmaxf(mt, sc[i]); }
      mt = swmax16(mt); mt = swmax32(mt);
      const float mn = fmaxf(m, mt);
      float ps = 0.f;
#pragma unroll
      for (int i = 0; i < 8; ++i) { const int key = k0 + (i >> 2) * 16 + quad * 4 + (i & 3); ps += key <= hi ? ex2(sc[i] - mn) : 0.f; }
      lsum = lsum * ex2(m - mn) + ps; m = mn;
    }
    lsum = swadd16(lsum); lsum = swadd32(lsum);
    const float inv = lsum > 0.f ? 1.f / lsum : 0.f;
    AttnSt s; attn_init(s, m, 0.f);
    for (int k0 = 0; k0 <= nmax; k0 += 32) {
      float sc[8];
      attn_scores(Kp, k0, q0, q1, r, quad, sc);
#pragma unroll
      for (int i = 0; i < 8; ++i) { const int key = k0 + (i >> 2) * 16 + quad * 4 + (i & 3); sc[i] = key <= hi ? ex2(sc[i] - m) * inv : 0.f; }
      const bf16x8 pb = pack8(sc[0], sc[1], sc[2], sc[3], sc[4], sc[5], sc[6], sc[7]);
      attn_pv(s, VTp, k0, pb, r, quad);
#pragma unroll
      for (int i = 0; i < 8; ++i) { sc[i] += xor1(sc[i]); sc[i] += xor2(sc[i]); }
      if ((r & 3) == 0) {
        const int j0 = (k0 >> 2) + quad;
        own4[tok * 256 + j0] = sc[0] + sc[1] + sc[2] + sc[3]; lastp[tok * 256 + j0] = sc[3];
        own4[tok * 256 + j0 + 4] = sc[4] + sc[5] + sc[6] + sc[7]; lastp[tok * 256 + j0 + 4] = sc[7];
      }
    }
#pragma unroll
    for (int dt = 0; dt < 4; ++dt)
#pragma unroll
      for (int i = 0; i < 4; ++i) resl[(dt * 4 + i) * 64 + lane] = s.o[dt][i] * g_cmp;
  }
  __builtin_amdgcn_wave_barrier();
  __builtin_amdgcn_s_waitcnt(0xc07f);
  for (int rp = 0; rp < ((NSAREP & 2) ? 2 : 1); ++rp) {
    const int cur = t0 >> 6;
    if (cur < 16) {
      sel[lane] = (lane & 15) + 1;
    } else {
#pragma unroll 1
      for (int tk = 0; tk < 4; ++tk) {
        unsigned u[4];
#pragma unroll
        for (int c = 0; c < 4; ++c) {
          const int j = lane + 64 * c;
          const bool forced = (j == 0) || (j == cur) || (j == cur - 1);
          float v = -1e9f;
          if (j <= cur) { v = own4[tk * 256 + j]; if (j > 0) v += lastp[tk * 256 + j - 1]; }
          const unsigned bb = __float_as_uint(v);
          u[c] = forced ? 0u : ((bb & 0x80000000u) ? ~bb : (bb | 0x80000000u));
        }
        unsigned prefix = 0u;
#pragma unroll 1
        for (int bit = 31; bit >= 0; --bit) {
          const unsigned trial = prefix | (1u << bit);
          int cnt = 0;
#pragma unroll
          for (int c = 0; c < 4; ++c) cnt += __builtin_popcountll(__builtin_amdgcn_ballot_w64(u[c] >= trial));
          if (cnt >= 13) prefix = trial;
        }
        int ngt = 0;
        unsigned long long mgt[4], meq[4];
#pragma unroll
        for (int c = 0; c < 4; ++c) { mgt[c] = __builtin_amdgcn_ballot_w64(u[c] > prefix); meq[c] = __builtin_amdgcn_ballot_w64(u[c] == prefix); ngt += __builtin_popcountll(mgt[c]); }
        const int need = 13 - ngt;
        int eqbase = 0, pos = 0;
#pragma unroll
        for (int c = 0; c < 4; ++c) {
          const int below_eq = __builtin_amdgcn_mbcnt_hi((unsigned)(meq[c] >> 32), __builtin_amdgcn_mbcnt_lo((unsigned)meq[c], 0u));
          const bool take = (u[c] > prefix) || ((u[c] == prefix) && (eqbase + below_eq < need));
          const unsigned long long mt = __builtin_amdgcn_ballot_w64(take);
          const int below = __builtin_amdgcn_mbcnt_hi((unsigned)(mt >> 32), __builtin_amdgcn_mbcnt_lo((unsigned)mt, 0u));
          if (take) sel[tk * 16 + pos + below] = lane + 64 * c;
          pos += __builtin_popcountll(mt);
          eqbase += __builtin_popcountll(meq[c]);
        }
      }
    }
  }
  __builtin_amdgcn_wave_barrier();
  __builtin_amdgcn_s_waitcnt(0xc07f);
  for (int rp = 0; rp < ((NSAREP & 4) ? 2 : 1); ++rp) {
    const bfr* Kp = parts + (size_t)2 * (4u * MBy) + (size_t)bg * L * 64;
    const bfr* VTp = parts + (size_t)3 * (4u * MBy) + (size_t)bg * 256 * 4096;
    AttnSt s; attn_init(s, NEGF, 0.f);
    {
      const int selv = sel[lane];
      const int cur = t0 >> 6;
      const int nnf = cur >= 16 ? 13 : (cur >= 2 ? cur - 2 : 0);
      const int nf = cur >= 2 ? 3 : cur + 1;
      auto uf = [&](int u) {
        UnitD d; d.Kp = Kp; d.VTp = VTp; d.lo = 0;
        if (u < 2 * nf) {
          const int fi = u >> 1, j = (fi == 0) ? 0 : (nf == 2 ? 1 : (fi == 1 ? cur - 1 : cur));
          d.key0 = j * 64 + (u & 1) * 32; d.colok = true; d.hi = tq; d.fast = j < cur;
        } else {
          const int v = u - 2 * nf, tk = v / (2 * nnf), rem = v - tk * 2 * nnf, k = rem >> 1;
          const int j = __builtin_amdgcn_readlane(selv, tk * 16 + k);
          d.key0 = j * 64 + (rem & 1) * 32; d.colok = (tok == tk); d.hi = d.colok ? t0 + tk : -1; d.fast = true;
        }
        return d; };
      attn_stream(s, 2 * nf + 8 * nnf, uf, q0, q1, lane);
    }
    const float l = attn_finish_l(s), inv = (l > 0.f ? g_slc / l : 0.f) * (rp == 0 ? 1.f : 1e-30f);
#pragma unroll
    for (int dt = 0; dt < 4; ++dt)
#pragma unroll
      for (int i = 0; i < 4; ++i) resl[(dt * 4 + i) * 64 + lane] += s.o[dt][i] * inv;
  }
  {
    const bfr* Kp = parts + (size_t)4 * (4u * MBy) + (size_t)bg * L * 64;
    const bfr* VTp = parts + (size_t)5 * (4u * MBy) + (size_t)bg * 256 * 4096;
    AttnSt s; attn_init(s, NEGF, 0.f);
    const int lo = tq - 511 > 0 ? tq - 511 : 0;
    int ks = t0 - 511; ks = ks < 0 ? 0 : (ks & ~31);
    const int n = ((t0 + 3) >> 5) - (ks >> 5) + 1;
    const int lomax = t0 + 3 - 511;
    auto uf = [&](int u) { UnitD d; d.Kp = Kp; d.VTp = VTp; d.key0 = ks + 32 * u; d.hi = tq; d.lo = lo; d.fast = (d.key0 >= lomax) && (d.key0 + 31 <= t0); d.colok = true; return d; };
    attn_stream(s, n, uf, q0, q1, lane);
    const float l = attn_finish_l(s), inv = l > 0.f ? g_win / l : 0.f;
#pragma unroll
    for (int dt = 0; dt < 4; ++dt) {
      f32x4 r4;
#pragma unroll
      for (int i = 0; i < 4; ++i) r4[i] = resl[(dt * 4 + i) * 64 + lane] + s.o[dt][i] * inv;
      s.o[dt] = r4;
    }
    bfr* mp = mix + ((size_t)b * L + tq) * DM + 512 + (g * 4 + (r & 3)) * 64 + quad * 4;
#pragma unroll
    for (int dt = 0; dt < 4; ++dt) *(u32x2*)(mp + dt * 16) = pk4(s.o[dt]);
  }
  __builtin_amdgcn_wave_barrier();
}

template <bool PASSB>
DI void s5_item(const Params& p, int oi, int witem, float* wl  ) {
  unsigned char* ws = p.ws;
  const float* us5 = (const float*)(ws + OFF_S);
  bfr* yg = (bfr*)(ws + OFF_S + 64 * MBy);
  float* S = (float*)(ws + OFF_S5S);
  const float* pre = (const float*)(ws + OFF_S5PRE) + (size_t)oi * 131072;
  const int lane = otid() & 63;
  const int bgi = witem >> 8, c = witem & 255, b = bgi >> 5, g = bgi & 31;
  const int gp = g * 64 + lane;
  const float lre = pre[gp * 2], lim = pre[gp * 2 + 1];
  float bre[16], bim[16];
#pragma unroll
  for (int h = 0; h < 16; ++h) { bre[h] = pre[8192 + gp * 32 + h]; bim[h] = pre[8192 + gp * 32 + 16 + h]; }
  const size_t tg0 = (size_t)b * L + c * 64;
  __builtin_amdgcn_wave_barrier();
#pragma unroll
  for (int i = 0; i < 4; ++i) {
    const int idx = i * 64 + lane, tt = idx >> 2, q = idx & 3;
    *(f32x4*)(wl + tt * 16 + q * 4) = *(const f32x4*)(us5 + (tg0 + tt) * 512 + g * 16 + q * 4);
  }
  __builtin_amdgcn_wave_barrier();
  __builtin_amdgcn_s_waitcnt(0xc07f);
  float xre = 0.f, xim = 0.f;
  if (PASSB) {
    const float Lre = pre[4096 + gp * 2], Lim = pre[4096 + gp * 2 + 1];
    const float* Sp = S + (size_t)bgi * 256 * 128;
    int cc = 0;
    for (; cc + 8 <= c; cc += 8) {
      float sr[8], si[8];
#pragma unroll
      for (int k = 0; k < 8; ++k) { sr[k] = Sp[(cc + k) * 128 + lane]; si[k] = Sp[(cc + k) * 128 + 64 + lane]; }
      asm volatile("" ::: "memory"); __builtin_amdgcn_sched_barrier(0);
#pragma unroll
      for (int k = 0; k < 8; ++k) { const float nr = Lre * xre - Lim * xim + sr[k], ni = Lre * xim + Lim * xre + si[k]; xre = nr; xim = ni; }
    }
    for (; cc < c; ++cc) {
      const float sr = Sp[cc * 128 + lane], si = Sp[cc * 128 + 64 + lane];
      const float nr = Lre * xre - Lim * xim + sr, ni = Lre * xim + Lim * xre + si;
      xre = nr; xim = ni;
    }
  }
  const int r16 = lane & 15, quad = lane >> 4;
  bf16x8 cf[4];
  f32x4 dsk4 = {0.f, 0.f, 0.f, 0.f};
  bfr* xl = (bfr*)(wl + 1024);
  if (PASSB) {
    const float* cr = p.in[27] + ((size_t)oi * 32 + g) * 16 * 64 + r16 * 64;
    const float* ci = p.in[28] + ((size_t)oi * 32 + g) * 16 * 64 + r16 * 64;
#pragma unroll
    for (int ks = 0; ks < 4; ++ks) {
      const float* src = (ks < 2 ? cr : ci) + (ks & 1) * 32 + quad * 8;
      const f32x4 a0 = *(const f32x4*)src, a1 = *(const f32x4*)(src + 4);
      const float sg = ks < 2 ? 1.f : -1.f;
      cf[ks] = pack8(sg * a0[0], sg * a0[1], sg * a0[2], sg * a0[3], sg * a1[0], sg * a1[1], sg * a1[2], sg * a1[3]);
    }
    dsk4 = *(const f32x4*)(p.in[29] + (size_t)oi * 512 + g * 16 + quad * 4);
  }
#pragma unroll 1
  for (int tb = 0; tb < 4; ++tb) {
#pragma unroll 2
    for (int t16 = 0; t16 < 16; ++t16) {
      const int tt = tb * 16 + t16;
      float u[16];
#pragma unroll
      for (int q = 0; q < 4; ++q) { const f32x4 v = *(const f32x4*)(wl + tt * 16 + q * 4); u[q * 4] = v[0]; u[q * 4 + 1] = v[1]; u[q * 4 + 2] = v[2]; u[q * 4 + 3] = v[3]; }
      float ar0 = 0.f, ar1 = 0.f, ai0 = 0.f, ai1 = 0.f;
#pragma unroll
      for (int h = 0; h < 16; h += 2) { ar0 += bre[h] * u[h]; ar1 += bre[h + 1] * u[h + 1]; ai0 += bim[h] * u[h]; ai1 += bim[h + 1] * u[h + 1]; }
      const float ar = ar0 + ar1, ai = ai0 + ai1;
      const float nr = lre * xre - lim * xim + ar, ni = lre * xim + lim * xre + ai;
      xre = nr; xim = ni;
      if (PASSB) { xl[t16 * 136 + lane] = f2bf(xre); xl[t16 * 136 + 64 + lane] = f2bf(xim); }
    }
    if (PASSB) {
      __builtin_amdgcn_wave_barrier();
      f32x4 y = {0.f, 0.f, 0.f, 0.f};
#pragma unroll
      for (int ks = 0; ks < 4; ++ks) y = MFMA16(cf[ks], *(const bf16x8*)(xl + r16 * 136 + ks * 32 + quad * 8), y);
      const int t = tb * 16 + r16;
      const f32x4 uu = *(const f32x4*)(wl + t * 16 + quad * 4);
      f32x4 o;
#pragma unroll
      for (int i = 0; i < 4; ++i) o[i] = gelu_tanh(y[i] + dsk4[i] * uu[i]);
      *(u32x2*)(yg + (tg0 + t) * 512 + g * 16 + quad * 4) = pk4(o);
      __builtin_amdgcn_wave_barrier();
    }
  }
  if (!PASSB) {
    float* Sp = S + ((size_t)bgi * 256 + c) * 128;
    Sp[lane] = xre; Sp[64 + lane] = xim;
  }
  __builtin_amdgcn_wave_barrier();
}

__global__ void __launch_bounds__(256, 2) fwd_mega(Params p) {
  __shared__ __attribute__((aligned(16))) unsigned char smem[56832];
  cg::grid_group grid = cg::this_grid();
  unsigned char* ws = p.ws;
  const int tid = threadIdx.x, wave = __builtin_amdgcn_readfirstlane(tid >> 6);
  float* rowss = (float*)(ws + OFF_ROWSS);
  bfr* hb = (bfr*)(ws + OFF_HB);
  bfr* mixb = (bfr*)(ws + OFF_MIX);
  __shared__ __attribute__((aligned(16))) unsigned xbw[4];
  __shared__ int xmw[4];
  if (tid == 0) { xbw[0] = 0u; xbw[1] = 0u; xbw[2] = 0u; xbw[3] = 0u; }
  __syncthreads();
  XcdBarrier xb; xb.bar = (unsigned*)(ws + OFF_BAR); xb.x = xb_xcc_id(); xb.st = (volatile LAS unsigned*)xbw;
  unsigned myloc = 0;
  if (tid == 0) myloc = xb_add(&xb.bar[XB_XCNT(xb.x)], 1u);
  for (int rep = 0; rep < (((REPMASK >> 15) & 1) ? 2 : 1); ++rep) {
  if (PHMASK & 1) prep_phase(p, smem);
  if (p.njobs < 0) grid.sync();
  xcd_barrier(xb);
  }
  if (tid == 0) {
    unsigned cnt[8], sum = 0, okf = 1;
    for (int j = 0; j < 8; ++j) { cnt[j] = xb_ld(&xb.bar[XB_XCNT(j)]); sum += cnt[j]; okf &= (cnt[j] > 0u) ? 1u : 0u; }
    okf &= (sum == gridDim.x) ? 1u : 0u; okf &= (xb.x < 8u) ? 1u : 0u;
    xmw[0] = (int)okf; xmw[1] = (int)xb.x; xmw[2] = (int)myloc; xmw[3] = (int)(xb.x < 8u ? cnt[xb.x] : 1u);
  }
  __syncthreads();
  XMap xm; xm.ok = xmw[0]; xm.xcd = xmw[1]; xm.loc = xmw[2]; xm.nloc = xmw[3];
  if (blockIdx.x == 0) {
    float* be = (float*)(ws + OFF_B1EFF);
    for (int o = tid; o < 1024; o += 256) { float sm = p.in[16][o]; for (int sl = 0; sl < 16; ++sl) sm += be[1024 + sl * 1024 + o]; be[o] = sm; }
  }
#pragma unroll 1
  for (int layer = 0; layer < 4; ++layer) {
    const int li = layer >> 1;
    const bool even = (layer & 1) == 0;
    const float* hin = layer == 0 ? p.in[0] : p.out;
    const int nst = even ? 8 : 7;
#pragma unroll 1
    for (int step = 0; step < nst; ++step) {
      GemmDesc d;
      d.kind = -1; d.rpart = nullptr; d.sA = 0; d.sB = 0; d.nbatch = 1;
      const int gk = even ? step : (step == 0 ? 8 : (step < 3 ? 8 + step : step + 1 + 6));
      const int code = even ? step : (step <= 2 ? 8 + step : (step == 3 ? 11 : (step == 4 ? 5 : step + 1)));
      (void)gk;
      const int nrep = ((REPMASK >> code) & 1) ? 2 : 1;
      for (int rep = 0; rep < nrep; ++rep) {
      switch (code) {
        case 0: {
          d.kind = 0; d.A = hb; d.lda = DM; d.Bt = (const bfr*)(ws + OFF_EVIN) + (size_t)li * EVIN_NP * 1024; d.ldb = 1024; d.M = T; d.N = EVIN_NP; d.K = 1024; d.rpart = rowss;
          d.e0 = EpiEvenIn{ws};
        } break;
        case 1: {
          if (PHMASK & 2) ssd_conv_phase(p, li, smem);
          d.kind = 5; d.A = (const bfr*)(ws + OFF_S + 128 * MBy); d.lda = 1024; d.sA = (size_t)4096 * 1024; d.Bt = (const bfr*)(ws + OFF_W1) + (size_t)li * 2 * 256 * 2048; d.ldb = 2048;
          d.sB = (size_t)256 * 2048; d.M = 4096; d.N = 256; d.K = 2048; d.nbatch = 2;
          d.e5 = EpiW1{ws, li};
        } break;
        case 2: {
          if (PHMASK & 4) for (int it = blockIdx.x; it < 512; it += gridDim.x) ssd_states_item(p, it * 4 + wave, (float*)smem + wave * 128);
          d.kind = 6; d.A = (const bfr*)(ws + OFF_NSAHID); d.lda = 256; d.sA = (size_t)4096 * 256; d.Bt = (const bfr*)(ws + OFF_W2) + (size_t)li * 2 * 128 * 256; d.ldb = 256;
          d.sB = (size_t)128 * 256; d.M = 4096; d.N = 128; d.K = 256; d.nbatch = 2;
          d.e6 = EpiW2{ws, p.in[18] + li * 128};
        } break;
        case 3: {
          if (rep == 0) for (int it = blockIdx.x; it < 512; it += gridDim.x) { if (PHMASK & 8) ssd_carry_item(p, it); }
          if (xm.ok) {
            const int bg = xm.xcd >> 1, sub = xm.xcd & 1;
            for (int k = xm.loc; k < 512; k += xm.nloc) { if (PHMASK & 16) nsa_item(p, bg * 4096 + (2 * k + sub) * 4 + wave, (float*)smem + wave * 3200); }
          } else {
            for (int it = blockIdx.x; it < 4096; it += gridDim.x) { if (PHMASK & 16) nsa_item(p, it * 4 + wave, (float*)smem + wave * 3200); }
          }
        } break;
        case 4: { if (PHMASK & 32) ssd_out_phase(p, li, smem); } break;
        case 5: {
          d.kind = 2; d.A = mixb; d.lda = DM; d.Bt = (even ? (const bfr*)(ws + OFF_EVOUT) : (const bfr*)(ws + OFF_ODOUT)) + (size_t)li * 1024 * 1024; d.ldb = 1024; d.M = T; d.N = 1024; d.K = 1024;
          d.e2 = EpiRes{hin, p.out, hb, rowss + (size_t)T * 16};
        } break;
        case 6: {
          d.kind = 3; d.A = hb; d.lda = DM; d.Bt = (const bfr*)(ws + OFF_WUP) + (size_t)layer * 4096 * 1024; d.ldb = 1024; d.M = T; d.N = 4096; d.K = 1024; d.rpart = rowss + (size_t)T * 16;
          d.e3 = EpiUp{ws};
        } break;
        case 7: {
          d.kind = 2; d.A = (const bfr*)(ws + OFF_S); d.lda = 4096; d.Bt = (const bfr*)(ws + OFF_WDN) + (size_t)layer * 1024 * 4096; d.ldb = 4096; d.M = T; d.N = 1024; d.K = 4096;
          d.e2 = EpiRes{p.out, p.out, hb, rowss};
        } break;
        case 8: {
          d.kind = 1; d.A = hb; d.lda = DM; d.Bt = (const bfr*)(ws + OFF_ODIN) + (size_t)li * 1280 * 1024; d.ldb = 1024; d.M = T; d.N = 1280; d.K = 1024; d.rpart = rowss;
          d.e1 = EpiOddIn{ws};
        } break;
        case 9: {
          for (int it = blockIdx.x; it < 4096; it += gridDim.x) { if (PHMASK & 64) s5_item<false>(p, li, it * 4 + wave, (float*)smem + wave * 2176); }
          if (xm.ok) {
            const int bg = xm.xcd >> 1, sub = xm.xcd & 1;
            for (int k = xm.loc; k < 512; k += xm.nloc) { if (PHMASK & 128) swa_item(p, li, bg * 4096 + (2 * k + sub) * 4 + wave); }
          } else {
            for (int it = blockIdx.x; it < 4096; it += gridDim.x) { if (PHMASK & 128) swa_item(p, li, it * 4 + wave); }
          }
        } break;
        case 10: { if (PHMASK & 256) for (int it = blockIdx.x; it < 4096; it += gridDim.x) s5_item<true>(p, li, it * 4 + wave, (float*)smem + wave * 2176); } break;
        default: {
          d.kind = 4; d.A = (const bfr*)(ws + OFF_S + 64 * MBy); d.lda = 512; d.Bt = (const bfr*)(ws + OFF_GLU) + (size_t)li * 512 * 512; d.ldb = 512; d.M = T; d.N = 512; d.K = 512;
          d.e4 = EpiGlu{ws, p.in[31] + li * 512};
        } break;
      }
      if ((PHMASK & 512) && d.kind >= 0) gemm_phase_(d, smem, xm);
      xcd_barrier(xb);
      }
    }
  }
  {
    const float* rs = rowss;
    const float* gf = p.in[3];
    const int lane = tid & 63;
    f32x4 gg[4];
#pragma unroll
    for (int i = 0; i < 4; ++i) gg[i] = *(const f32x4*)(gf + (i * 64 + lane) * 4);
#pragma unroll 1
    for (int row = (blockIdx.x * 4 + wave) * 2; row < T; row += gridDim.x * 8) {
      f32x4 v[2][4], pr[2][4];
#pragma unroll
      for (int rr = 0; rr < 2; ++rr) {
#pragma unroll
        for (int q = 0; q < 4; ++q) pr[rr][q] = *(const f32x4*)(rs + (size_t)(row + rr) * 16 + q * 4);
#pragma unroll
        for (int i = 0; i < 4; ++i) v[rr][i] = *(const f32x4*)(p.out + (size_t)(row + rr) * DM + (i * 64 + lane) * 4);
      }
      asm volatile("" ::: "memory"); __builtin_amdgcn_sched_barrier(0);
#pragma unroll
      for (int rr = 0; rr < 2; ++rr) {
        float sm = 0.f;
#pragma unroll
        for (int q = 0; q < 4; ++q) { sm += pr[rr][q][0]; sm += pr[rr][q][1]; sm += pr[rr][q][2]; sm += pr[rr][q][3]; }
        const float r = rsqrtf(sm * (1.f / DM) + EPS);
#pragma unroll
        for (int i = 0; i < 4; ++i) *(f32x4*)(p.out + (size_t)(row + rr) * DM + (i * 64 + lane) * 4) = v[rr][i] * gg[i] * r;
      }
    }
  }
}

extern "C" void kernel_launch(void* const* d_in, const int* in_sizes, int n_in, void* d_out, int out_size, void* d_ws, size_t ws_size, hipStream_t stream) {
  static int grid_blocks = 0;
  if (!grid_blocks) {
    int dev = 0, cus = 0, per_cu = 0;
    hipGetDevice(&dev);
    hipDeviceGetAttribute(&cus, hipDeviceAttributeMultiprocessorCount, dev);
    hipOccupancyMaxActiveBlocksPerMultiprocessor(&per_cu, fwd_mega, 256, 0);
    if (per_cu > 2) per_cu = 2;
    grid_blocks = cus * per_cu;
    if (ws_size < WS_NEED) { fprintf(stderr, "workspace too small: %zu < %zu\n", ws_size, (size_t)WS_NEED); grid_blocks = -1; }
  }
  if (grid_blocks <= 0) return;
  Params p{};
  for (int i = 0; i < 32 && i < n_in; ++i) p.in[i] = (const float*)d_in[i];
  p.out = (float*)d_out;
  p.ws = (unsigned char*)d_ws;
  unsigned char* ws = (unsigned char*)d_ws;
  int nj = 0, t0 = 0;
  auto add = [&](const float* src, size_t dstoff, const float* scale, int K, int N) {
    TJob& j = p.jobs[nj++];
    j.src = src; j.dst = (bfr*)(ws + dstoff); j.scale = scale; j.K = K; j.N = N; j.tile0 = t0; j.pad = 0;
    t0 += (K / 64) * (N / 32);
  };
  const float* const* in = (const float* const*)d_in;
  for (int l = 0; l < 4; ++l) {
    add(in[4] + (size_t)l * 1024 * 4096, OFF_WUP + (size_t)l * 4096 * 1024 * 2, in[2] + l * 1024, 1024, 4096);
    add(in[5] + (size_t)l * 4096 * 1024, OFF_WDN + (size_t)l * 1024 * 4096 * 2, nullptr, 4096, 1024);
  }
  for (int i = 0; i < 2; ++i) {
    add(in[6] + (size_t)i * 1024 * EVIN_N, OFF_EVIN + (size_t)i * EVIN_NP * 1024 * 2, in[1] + (2 * i) * 1024, 1024, EVIN_N);
    add(in[7] + (size_t)i * 1024 * 1024, OFF_EVOUT + (size_t)i * 1024 * 1024 * 2, nullptr, 1024, 1024);
    add(in[19] + (size_t)i * 1024 * 1280, OFF_ODIN + (size_t)i * 1280 * 1024 * 2, in[1] + (2 * i + 1) * 1024, 1024, 1280);
    add(in[20] + (size_t)i * 1024 * 1024, OFF_ODOUT + (size_t)i * 1024 * 1024 * 2, nullptr, 1024, 1024);
    add(in[30] + (size_t)i * 512 * 512, OFF_GLU + (size_t)i * 512 * 512 * 2, nullptr, 512, 512);
    for (int kv = 0; kv < 2; ++kv) {
      add(in[15] + (size_t)(i * 2 + kv) * 2048 * 256, OFF_W1 + (size_t)(i * 2 + kv) * 256 * 2048 * 2, nullptr, 2048, 256);
      add(in[17] + (size_t)(i * 2 + kv) * 256 * 64, OFF_W2 + (size_t)(i * 2 + kv) * 128 * 256 * 2, nullptr, 256, 64);
    }
  }
  p.njobs = nj; p.ntile_total = t0;
  hipMemsetAsync((unsigned char*)d_ws + OFF_BAR, 0, 16384, stream);
  void* args[] = {&p};
  hipError_t e = hipLaunchCooperativeKernel((void*)fwd_mega, dim3(grid_blocks), dim3(256), args, 0, stream);
  if (e != hipSuccess) fprintf(stderr, "cooperative launch failed: %s (grid %d)\n", hipGetErrorString(e), grid_blocks);
}
```

```cpp
#include <hip/hip_runtime.h>
#include <hip/hip_cooperative_groups.h>
#include <cstdio>
namespace cg = cooperative_groups;

typedef unsigned short bfr;
typedef short bf16x8 __attribute__((ext_vector_type(8)));
typedef short bf16x4 __attribute__((ext_vector_type(4)));
typedef float f32x2 __attribute__((ext_vector_type(2)));
typedef float f32x4 __attribute__((ext_vector_type(4)));
typedef float f32x16 __attribute__((ext_vector_type(16)));
typedef unsigned u32x4 __attribute__((ext_vector_type(4)));
typedef unsigned u32x2 __attribute__((ext_vector_type(2)));
typedef __bf16 bfv2 __attribute__((ext_vector_type(2)));
#define DI __device__ __forceinline__
#define MFMA32(a, b, c) __builtin_amdgcn_mfma_f32_32x32x16_bf16((a), (b), (c), 0, 0, 0)
#define MFMA16(a, b, c) __builtin_amdgcn_mfma_f32_16x16x32_bf16((a), (b), (c), 0, 0, 0)

#ifndef GEMMSEL
#define GEMMSEL 0xffff
#endif
#ifndef NSAREP
#define NSAREP 0
#endif
#ifndef REPMASK
#define REPMASK 0
#endif
#ifndef PHMASK
#define PHMASK 1023
#endif
constexpr int T = 32768, L = 16384, DM = 1024;
constexpr float EPS = 1e-6f;
constexpr float NEGF = -1e30f;
constexpr float QSC = 0.125f * 1.4426950408889634f;
constexpr float LOG2E = 1.4426950408889634f;
constexpr size_t MBy = 1u << 20;
constexpr size_t OFF_WUP = 0, OFF_WDN = 32 * MBy, OFF_EVIN = 64 * MBy, OFF_EVOUT = 76 * MBy, OFF_ODIN = 80 * MBy, OFF_ODOUT = 86 * MBy,
                 OFF_GLU = 90 * MBy, OFF_W1 = 91 * MBy, OFF_W2 = 95 * MBy, OFF_ROWSS = 120 * MBy, OFF_S5PRE = 98 * MBy, OFF_B1EFF = 99 * MBy,
                 OFF_DTRAW = 100 * MBy, OFF_DTT = 101 * MBy, OFF_ACUM = 102 * MBy, OFF_CDEC = 103 * MBy, OFF_GATES = 104 * MBy,
                 OFF_NSAHID = 107 * MBy, OFF_KC = 111 * MBy, OFF_VCT = 111 * MBy + 512 * 1024, OFF_S5S = 112 * MBy, OFF_HB = 124 * MBy,
                 OFF_MIX = 188 * MBy, OFF_S = 252 * MBy, OFF_BAR = 508 * MBy, WS_NEED = 508 * MBy + 65536;
constexpr int EVIN_N = 2848, EVIN_NP = 2944;

struct TJob { const float* src; bfr* dst; const float* scale; int K, N, tile0, pad; };
struct Params {
  const float* in[32];
  float* out;
  unsigned char* ws;
  TJob jobs[26];
  int njobs, ntile_total;
};

DI unsigned pk2(float a, float b) { f32x2 v = {a, b}; return __builtin_bit_cast(unsigned, __builtin_convertvector(v, bfv2)); }
DI bfr f2bf(float a) { return (bfr)(pk2(a, 0.f) & 0xffffu); }
DI float bf2f(bfr x) { return __uint_as_float(((unsigned)x) << 16); }
DI float bflo(unsigned u) { return __uint_as_float(u << 16); }
DI float bfhi(unsigned u) { return __uint_as_float(u & 0xffff0000u); }
DI bf16x8 pack8(float a, float b, float c, float d, float e, float f, float g, float h) {
  u32x4 r = {pk2(a, b), pk2(c, d), pk2(e, f), pk2(g, h)};
  return __builtin_bit_cast(bf16x8, r);
}
DI bf16x8 ld8(const bfr* p) { return *(const bf16x8*)p; }
DI int crow(int i, int half) { return (i & 3) + 8 * (i >> 2) + 4 * half; }
DI float sigmoidf_(float x) { return 1.f / (1.f + __expf(-x)); }
DI float siluf_(float x) { return x / (1.f + __expf(-x)); }
DI float gelu_tanh(float x) {
  float z = 0.7978845608028654f * (x + 0.044715f * x * x * x);
  float t = 1.f - 2.f / (__expf(2.f * z) + 1.f);
  return 0.5f * x * (1.f + t);
}
DI int otid() { int t = threadIdx.x; asm volatile("" : "+v"(t)); return t; }
DI float ex2(float x) { return __builtin_amdgcn_exp2f(x); }
typedef unsigned u2v __attribute__((ext_vector_type(2)));
DI float swsum32(float x, float y) { const u2v r = __builtin_amdgcn_permlane32_swap(__float_as_uint(x), __float_as_uint(y), false, false); return __uint_as_float(r[0]) + __uint_as_float(r[1]); }
DI float swsum16(float x, float y) { const u2v r = __builtin_amdgcn_permlane16_swap(__float_as_uint(x), __float_as_uint(y), false, false); return __uint_as_float(r[0]) + __uint_as_float(r[1]); }
template <int CTRL> DI float dppf(float v) { return __int_as_float(__builtin_amdgcn_mov_dpp(__float_as_int(v), CTRL, 0xf, 0xf, true)); }
DI float xor1(float v) { return dppf<0xB1>(v); }
DI float xor2(float v) { return dppf<0x4E>(v); }
DI float rmir(float v) { return dppf<0x140>(v); }
DI float rhmir(float v) { return dppf<0x141>(v); }
DI float swmax32(float x) { const u2v r = __builtin_amdgcn_permlane32_swap(__float_as_uint(x), __float_as_uint(x), false, false); return fmaxf(__uint_as_float(r[0]), __uint_as_float(r[1])); }
DI float swmax16(float x) { const u2v r = __builtin_amdgcn_permlane16_swap(__float_as_uint(x), __float_as_uint(x), false, false); return fmaxf(__uint_as_float(r[0]), __uint_as_float(r[1])); }
DI float swadd32(float x) { const u2v r = __builtin_amdgcn_permlane32_swap(__float_as_uint(x), __float_as_uint(x), false, false); return __uint_as_float(r[0]) + __uint_as_float(r[1]); }
DI float swadd16(float x) { const u2v r = __builtin_amdgcn_permlane16_swap(__float_as_uint(x), __float_as_uint(x), false, false); return __uint_as_float(r[0]) + __uint_as_float(r[1]); }
DI float shx(float v, int m) { return __shfl_xor(v, m, 64); }

#define XB_TMO      128
#define XB_XCNT(j)  (256  + 64 * (j))
#define XB_XSUB(j)  (1280 + 64 * (j))
#define XB_XGEN(j)  (2304 + 64 * (j))
#define XB_TOP      3328
#define XB_TOPGEN   3392
#define XCD_BAR_WORDS 3456
#define XB_SPIN_CAP (1u << 20)
#define LAS __attribute__((address_space(3)))
DI unsigned xb_ld(unsigned* p) { return __hip_atomic_load(p, __ATOMIC_RELAXED, __HIP_MEMORY_SCOPE_AGENT); }
DI unsigned xb_add(unsigned* p, unsigned v) { return __hip_atomic_fetch_add(p, v, __ATOMIC_RELAXED, __HIP_MEMORY_SCOPE_AGENT); }
DI unsigned xb_xcc_id() { return (unsigned)__builtin_amdgcn_s_getreg((3 << 11) | 20) & 0xFu; }
#define XB_SPIN(cond, bar) do { unsigned _sp = 0; while (cond) { __builtin_amdgcn_s_sleep(1); \
    if ((++_sp & 255u) == 0u) { if (xb_ld(&(bar)[XB_TMO])) break; if (_sp > XB_SPIN_CAP) { atomicAdd(&(bar)[XB_TMO], 1u); break; } } } } while (0)
struct XcdBarrier { unsigned* bar; unsigned x; volatile LAS unsigned* st; };
DI void xcd_barrier_complete(unsigned* bar, unsigned x, unsigned& nloc, unsigned& nx) {
  const unsigned G = gridDim.x * gridDim.y * gridDim.z;
  unsigned sum, cnt, mine, sp = 0u;
  for (;;) {
    sum = 0u; cnt = 0u; mine = 0u;
#pragma unroll
    for (unsigned j = 0; j < 16; ++j) { const unsigned c = xb_ld(&bar[XB_XCNT(j)]); sum += c; cnt += (c > 0u) ? 1u : 0u; mine = (j == x) ? c : mine; }
    if (sum == G) break;
    __builtin_amdgcn_s_sleep(1);
    if ((++sp & 255u) == 0u) { if (xb_ld(&bar[XB_TMO])) break; if (sp > XB_SPIN_CAP) { atomicAdd(&bar[XB_TMO], 1u); break; } }
  }
  nloc = mine > 0u ? mine : 1u; nx = cnt > 0u ? cnt : 1u;
}
DI void xcd_barrier(const XcdBarrier& b) {
  asm volatile("s_waitcnt vmcnt(0)" ::: "memory");
  __syncthreads();
  if (threadIdx.x == 0) {
    unsigned* bar = b.bar;
    __builtin_amdgcn_s_waitcnt(0);
    unsigned nloc = b.st[0], nx = b.st[1];
    if (nloc == 0u) { xcd_barrier_complete(bar, b.x, nloc, nx); b.st[0] = nloc; b.st[1] = nx; }
    const unsigned old = xb_add(&bar[XB_XSUB(b.x)], 1u);
    const unsigned gen = old / nloc;
    if (old + 1u == (gen + 1u) * nloc) {
      __builtin_amdgcn_fence(__ATOMIC_RELEASE, "agent");
      asm volatile("s_waitcnt vmcnt(0)" ::: "memory");
      const unsigned og = xb_add(&bar[XB_TOP], 1u);
      const unsigned tg = og / nx;
      if (og + 1u == (tg + 1u) * nx) xb_add(&bar[XB_TOPGEN], 1u);
      else XB_SPIN(xb_ld(&bar[XB_TOPGEN]) == tg, bar);
      __builtin_amdgcn_fence(__ATOMIC_ACQUIRE, "agent");
      xb_add(&bar[XB_XGEN(b.x)], 1u);
      asm volatile("s_waitcnt vmcnt(0)" ::: "memory");
    } else {
      XB_SPIN(xb_ld(&bar[XB_XGEN(b.x)]) == gen, bar);
      __builtin_amdgcn_fence(__ATOMIC_ACQUIRE, "agent");
      asm volatile("s_waitcnt vmcnt(0)" ::: "memory");
    }
  }
  __syncthreads();
}
struct XMap { int ok, xcd, loc, nloc; };

DI int vpos(int k64) { const int k = k64 & 31; return (k64 & 32) + ((k & 15) >> 2) * 8 + (k >> 4) * 4 + (k & 3); }
DI size_t kfoff(int key, int d) { return ((size_t)((key >> 4) * 2 + (d >> 5)) * 64 + ((d & 31) >> 3) * 16 + (key & 15)) * 8 + (d & 7); }
DI size_t vfoff(int key, int d) { return ((size_t)((key >> 5) * 4 + (d >> 4)) * 64 + ((key & 15) >> 2) * 16 + (d & 15)) * 8 + ((key >> 4) & 1) * 4 + (key & 3); }
DI u32x2 pk4(const f32x4& v) { u32x2 r = {pk2(v[0], v[1]), pk2(v[2], v[3])}; return r; }
struct EpiEvenIn {
  unsigned char* ws;
  DI void operator()(int, int t, int col, f32x4 v, float rs) const {
    if (col >= EVIN_N) return;
    bfr* zb = (bfr*)(ws + OFF_S + 64 * MBy); bfr* xraw = (bfr*)(ws + OFF_S); float* dtraw = (float*)(ws + OFF_DTRAW); bfr* qn = (bfr*)(ws + OFF_S + 96 * MBy); bfr* parts = (bfr*)(ws + OFF_S + 128 * MBy); float* gates = (float*)(ws + OFF_GATES);
    v *= rs;
    if (col < 512) *(u32x2*)(zb + (size_t)t * 512 + col) = pk4(v);
    else if (col < 1536) *(u32x2*)(xraw + (size_t)t * 1024 + col - 512) = pk4(v);
    else if (col < 1544) *(f32x4*)(dtraw + (size_t)t * 8 + col - 1536) = v;
    else if (col < 2056) *(u32x2*)(qn + (size_t)t * 512 + col - 1544) = pk4(v * QSC);
    else if (col < 2824) {
      const int w = col - 2056, part = w >> 7, g = (w >> 6) & 1, d = w & 63, b = t >> 14, tl = t & (L - 1);
      bfr* pb = parts + (size_t)part * (4u * MBy);
      if (part == 3 || part == 5) {
        bfr* q = pb + (size_t)(b * 2 + g) * L * 64 + vfoff(tl, d);
        q[0] = f2bf(v[0]); q[8] = f2bf(v[1]); q[16] = f2bf(v[2]); q[24] = f2bf(v[3]);
      } else if (part < 2) *(u32x2*)(pb + ((size_t)(b * 2 + g) * L + tl) * 64 + d) = pk4(v);
      else *(u32x2*)(pb + (size_t)(b * 2 + g) * L * 64 + kfoff(tl, d)) = pk4(v);
    } else {
      f32x4 o = {sigmoidf_(v[0]), sigmoidf_(v[1]), sigmoidf_(v[2]), sigmoidf_(v[3])};
      *(f32x4*)(gates + (size_t)t * 24 + col - 2824) = o;
    }
  }
};
struct EpiOddIn {
  unsigned char* ws;
  DI void operator()(int, int t, int col, f32x4 v, float rs) const {
    bfr* qn = (bfr*)(ws + OFF_S + 96 * MBy); bfr* ksw = (bfr*)(ws + OFF_S + 128 * MBy); bfr* vswT = (bfr*)(ws + OFF_S + 136 * MBy); float* us5 = (float*)(ws + OFF_S);
    v *= rs;
    const int b = t >> 14, tl = t & (L - 1);
    if (col < 512) *(u32x2*)(qn + (size_t)t * 512 + col) = pk4(v * QSC);
    else if (col < 640) { const int g = (col - 512) >> 6, d = col & 63; *(u32x2*)(ksw + (size_t)(b * 2 + g) * L * 64 + kfoff(tl, d)) = pk4(v); }
    else if (col < 768) {
      const int g = (col - 640) >> 6, d = col & 63;
      bfr* q = vswT + (size_t)(b * 2 + g) * L * 64 + vfoff(tl, d);
      q[0] = f2bf(v[0]); q[8] = f2bf(v[1]); q[16] = f2bf(v[2]); q[24] = f2bf(v[3]);
    } else *(f32x4*)(us5 + (size_t)t * 512 + col - 768) = v;
  }
};
struct EpiRes {
  const float* hin; float* hout; bfr* hb; float* rowss_next;
  DI void operator()(int, int t, int col, f32x4 a, float) const {
    const f32x4 v = *(const f32x4*)(hin + (size_t)t * DM + col) + a;
    *(f32x4*)(hout + (size_t)t * DM + col) = v;
    *(u32x2*)(hb + (size_t)t * DM + col) = pk4(v);
    float s = v[0] * v[0] + v[1] * v[1] + v[2] * v[2] + v[3] * v[3];
    s += shx(s, 1); s += shx(s, 2); s += shx(s, 4);
    if ((threadIdx.x & 7) == 0) {
      float* pp = rowss_next + (size_t)t * 16 + (col >> 6);
      if (col & 32) s += *pp;
      *pp = s;
    }
  }
};
struct EpiUp {
  unsigned char* ws;
  DI void operator()(int, int t, int col, f32x4 v, float rs) const {
    bfr* hid = (bfr*)(ws + OFF_S);
    v *= rs;
#pragma unroll
    for (int i = 0; i < 4; ++i) v[i] = v[i] > 0.f ? v[i] * v[i] : 0.f;
    *(u32x2*)(hid + (size_t)t * 4096 + col) = pk4(v);
  }
};
struct EpiGlu {
  unsigned char* ws; const float* bias;
  DI void operator()(int, int t, int col, f32x4 a, float) const {
    const bfr* yg = (const bfr*)(ws + OFF_S + 64 * MBy); bfr* mix = (bfr*)(ws + OFF_MIX);
    const u32x2 yv = *(const u32x2*)(yg + (size_t)t * 512 + col);
    const f32x4 bb = *(const f32x4*)(bias + col);
    f32x4 o = {bflo(yv[0]) * sigmoidf_(a[0] + bb[0]), bfhi(yv[0]) * sigmoidf_(a[1] + bb[1]), bflo(yv[1]) * sigmoidf_(a[2] + bb[2]), bfhi(yv[1]) * sigmoidf_(a[3] + bb[3])};
    *(u32x2*)(mix + (size_t)t * DM + 512 + col) = pk4(o);
  }
};
struct EpiW1 {
  unsigned char* ws; int li;
  DI void operator()(int z, int r, int col, f32x4 a, float) const {
    const float* b1eff = (const float*)(ws + OFF_B1EFF) + li * 512; bfr* hid = (bfr*)(ws + OFF_NSAHID);
    const f32x4 bb = *(const f32x4*)(b1eff + z * 256 + col);
    f32x4 o = {gelu_tanh(a[0] + bb[0]), gelu_tanh(a[1] + bb[1]), gelu_tanh(a[2] + bb[2]), gelu_tanh(a[3] + bb[3])};
    *(u32x2*)(hid + ((size_t)z * 4096 + r) * 256 + col) = pk4(o);
  }
};
struct EpiW2 {
  unsigned char* ws; const float* b2;
  DI void operator()(int z, int r, int col, f32x4 a, float) const {
    if (col >= 64) return;
    bfr* kc = (bfr*)(ws + OFF_KC); bfr* vcT = (bfr*)(ws + OFF_VCT);
    const int bg = r >> 10, n = r & 1023;
    const f32x4 bb = *(const f32x4*)(b2 + z * 64 + col);
    f32x4 v = a + bb;
    if (n == 1023) v = (f32x4){0.f, 0.f, 0.f, 0.f};
    if (z == 0) *(u32x2*)(kc + (size_t)bg * 1024 * 64 + kfoff(n, col)) = pk4(v);
    else {
      bfr* q = vcT + (size_t)bg * 1024 * 64 + vfoff(n, col);
      q[0] = f2bf(v[0]); q[8] = f2bf(v[1]); q[16] = f2bf(v[2]); q[24] = f2bf(v[3]);
    }
  }
};

struct GemmDesc {
  const bfr* A; const bfr* Bt; const float* rpart; size_t sA, sB; int lda, ldb, M, N, K, nbatch, kind;
  EpiEvenIn e0; EpiOddIn e1; EpiRes e2; EpiUp e3; EpiGlu e4; EpiW1 e5; EpiW2 e6;
};
DI void epi_dispatch(const GemmDesc& d, int z, int row, int col, const f32x4& a, float rs) {
  switch (d.kind) {
    case 0: d.e0(z, row, col, a, rs); break;
    case 1: d.e1(z, row, col, a, rs); break;
    case 2: d.e2(z, row, col, a, rs); break;
    case 3: d.e3(z, row, col, a, rs); break;
    case 4: d.e4(z, row, col, a, rs); break;
    case 5: d.e5(z, row, col, a, rs); break;
    default: d.e6(z, row, col, a, rs); break;
  }
}
constexpr int GLD = 72;
DI void gemm_phase_(const GemmDesc& d, unsigned char* smem, const XMap& xm) {
  const bfr* __restrict__ A = d.A; const bfr* __restrict__ Bt = d.Bt; const float* rpart = d.rpart;
  const int lda = d.lda, ldb = d.ldb, M = d.M, N = d.N, K = d.K, nbatch = d.nbatch; const size_t sA = d.sA, sB = d.sB;
  bfr* sAq = (bfr*)smem;
  bfr* sBq = sAq + 256 * GLD;
  const int tid = otid(), lane = tid & 63, wave = tid >> 6, wm = wave >> 1, wn = wave & 1, half = lane >> 5, l32 = lane & 31;
  const int MT = M / 256, NT = N / 128, KT = K / 64;
  const int per = MT * NT, ntile = per * nbatch;
  const bool xmap = xm.ok && (((MT * nbatch) & 63) == 0);
  const int nloc = xm.nloc, xcd = xm.xcd, loc = xm.loc, MTx = (MT * nbatch) >> 3;
  const int tstart = xmap ? loc : blockIdx.x, tstep = xmap ? nloc : gridDim.x, tend = xmap ? MTx * NT : ntile;
  const int lrow = tid >> 3, lcc = (tid & 7) * 8;
  u32x4 ra[8], rb[4];
  const bfr* Ap = A; const bfr* Bp = Bt;
  int z = 0, mt = 0, nt = 0;
#define DECODE(TILE, Z, MTv, NTv) { if (xmap) { const int grp = (TILE) / (8 * NT), rem = (TILE) - grp * 8 * NT; NTv = rem >> 3; const int mg = xcd * MTx + grp * 8 + (rem & 7); Z = mg / MT; MTv = mg - Z * MT; } \
    else { Z = (TILE) / per; const int id = (TILE) % per; const int grp = id / (16 * NT), rem = id % (16 * NT); const int gm = (MT - grp * 16) < 16 ? (MT - grp * 16) : 16; MTv = grp * 16 + rem % gm; NTv = rem / gm; } }
#define GLOADS(K0) { _Pragma("unroll") for (int i = 0; i < 8; ++i) ra[i] = *(const u32x4*)(Ap + (size_t)(32 * i) * lda + (K0)); \
                     _Pragma("unroll") for (int i = 0; i < 4; ++i) rb[i] = *(const u32x4*)(Bp + (size_t)(32 * i) * ldb + (K0)); }
  for (int tile = tstart; tile < tend; tile += tstep) {
    DECODE(tile, z, mt, nt);
    Ap = A + z * sA + (size_t)(mt * 256 + lrow) * lda + lcc;
    Bp = Bt + z * sB + (size_t)(nt * 128 + lrow) * ldb + lcc;
    GLOADS(0);
    f32x16 acc[4][2];
#pragma unroll
    for (int i = 0; i < 4; ++i)
#pragma unroll
      for (int j = 0; j < 2; ++j)
#pragma unroll
        for (int r = 0; r < 16; ++r) acc[i][j][r] = 0.f;
    for (int kt = 0; kt < KT; ++kt) {
      __syncthreads();
#pragma unroll
      for (int i = 0; i < 8; ++i) *(u32x4*)(sAq + (lrow + 32 * i) * GLD + lcc) = ra[i];
#pragma unroll
      for (int i = 0; i < 4; ++i) *(u32x4*)(sBq + (lrow + 32 * i) * GLD + lcc) = rb[i];
      __syncthreads();
      if (kt + 1 < KT) GLOADS((kt + 1) * 64);
      __builtin_amdgcn_s_setprio(3);
#pragma unroll
      for (int ks = 0; ks < 4; ++ks) {
        bf16x8 bq[2];
#pragma unroll
        for (int j = 0; j < 2; ++j) bq[j] = *(const bf16x8*)(sBq + (wn * 64 + j * 32 + l32) * GLD + ks * 16 + half * 8);
#pragma unroll
        for (int ih = 0; ih < 2; ++ih) {
          bf16x8 af[2];
#pragma unroll
          for (int i = 0; i < 2; ++i) af[i] = *(const bf16x8*)(sAq + (wm * 128 + (ih * 2 + i) * 32 + l32) * GLD + ks * 16 + half * 8);
#pragma unroll
          for (int i = 0; i < 2; ++i)
#pragma unroll
            for (int j = 0; j < 2; ++j) acc[ih * 2 + i][j] = MFMA32(af[i], bq[j], acc[ih * 2 + i][j]);
        }
      }
      __builtin_amdgcn_s_setprio(0);
    }
    const int zc = z, mtc = mt, ntc = nt;
    __syncthreads();
    float* rsl = (float*)smem + 13824;
    if (rpart) {
      {
        const float* pp = rpart + (size_t)(mtc * 256 + tid) * 16;
        float sm = 0.f;
#pragma unroll
        for (int q = 0; q < 4; ++q) { const f32x4 v = *(const f32x4*)(pp + q * 4); sm += v[0]; sm += v[1]; sm += v[2]; sm += v[3]; }
        rsl[tid] = rsqrtf(sm * (1.f / DM) + EPS);
      }
      __syncthreads();
    }
    {
      float* eb = (float*)smem + wave * 2304;
      const int er = lane >> 3, ec = (lane & 7) * 4;
#pragma unroll
      for (int ip = 0; ip < 2; ++ip)
#pragma unroll
        for (int j = 0; j < 2; ++j) {
#pragma unroll
          for (int i = 0; i < 2; ++i)
#pragma unroll
            for (int e = 0; e < 16; ++e) eb[(i * 32 + crow(e, half)) * 36 + l32] = acc[ip * 2 + i][j][e];
          __builtin_amdgcn_wave_barrier();
          const int colg = ntc * 128 + wn * 64 + j * 32 + ec, rowl = wm * 128 + ip * 64 + er, rowg = mtc * 256 + rowl;
          if (d.kind == 2) {
#pragma unroll
            for (int kb = 0; kb < 8; kb += 4) {
              f32x4 hv[4];
#pragma unroll
              for (int k = 0; k < 4; ++k) hv[k] = *(const f32x4*)(d.e2.hin + (size_t)(rowg + 8 * (kb + k)) * DM + colg);
              asm volatile("" ::: "memory"); __builtin_amdgcn_sched_barrier(0);
#pragma unroll
              for (int k = 0; k < 4; ++k) {
                const int t = rowg + 8 * (kb + k);
                const f32x4 v = *(const f32x4*)(eb + ((kb + k) * 8 + er) * 36 + ec) + hv[k];
                *(f32x4*)(d.e2.hout + (size_t)t * DM + colg) = v;
                *(u32x2*)(d.e2.hb + (size_t)t * DM + colg) = pk4(v);
                float sq = v[0] * v[0] + v[1] * v[1] + v[2] * v[2] + v[3] * v[3];
                sq += xor1(sq); sq += xor2(sq); sq += rhmir(sq);
                if ((lane & 7) == 0) {
                  float* pp = d.e2.rowss_next + (size_t)t * 16 + (colg >> 6);
                  if (colg & 32) sq += *pp;
                  *pp = sq;
                }
              }
              asm volatile("" ::: "memory");
            }
          } else if (d.kind == 4) {
            const bfr* ygp = (const bfr*)(d.e4.ws + OFF_S + 64 * MBy);
            bfr* mixp = (bfr*)(d.e4.ws + OFF_MIX);
            const f32x4 bb = *(const f32x4*)(d.e4.bias + colg);
            u32x2 yv[8];
#pragma unroll
            for (int k = 0; k < 8; ++k) yv[k] = *(const u32x2*)(ygp + (size_t)(rowg + 8 * k) * 512 + colg);
            asm volatile("" ::: "memory"); __builtin_amdgcn_sched_barrier(0);
#pragma unroll
            for (int k = 0; k < 8; ++k) {
              const f32x4 a = *(const f32x4*)(eb + (k * 8 + er) * 36 + ec);
              f32x4 o = {bflo(yv[k][0]) * sigmoidf_(a[0] + bb[0]), bfhi(yv[k][0]) * sigmoidf_(a[1] + bb[1]), bflo(yv[k][1]) * sigmoidf_(a[2] + bb[2]), bfhi(yv[k][1]) * sigmoidf_(a[3] + bb[3])};
              *(u32x2*)(mixp + (size_t)(rowg + 8 * k) * DM + 512 + colg) = pk4(o);
            }
          } else {
#pragma unroll 2
            for (int k = 0; k < 8; ++k) {
              const f32x4 v = *(const f32x4*)(eb + (k * 8 + er) * 36 + ec);
              epi_dispatch(d, zc, rowg + 8 * k, colg, v, rpart ? rsl[rowl + 8 * k] : 1.f);
            }
          }
          __builtin_amdgcn_wave_barrier();
        }
    }
  }
#undef GLOADS
#undef DECODE
}

DI void prep_phase(const Params& p, unsigned char* smem) {
  const int tid = otid(), lane = tid & 63, wave = tid >> 6;
  unsigned char* ws = p.ws;
  float (*tl)[33] = (float (*)[33])smem;
  for (int tix = blockIdx.x; tix < p.ntile_total; tix += gridDim.x) {
    int j = 0;
    while (j + 1 < p.njobs && p.jobs[j + 1].tile0 <= tix) ++j;
    const TJob& jb = p.jobs[j];
    const int loc = tix - jb.tile0, ntn = jb.N / 32, kt = loc / ntn, nt = loc % ntn;
    __syncthreads();
#pragma unroll
    for (int i = 0; i < 8; ++i) {
      const int r = (tid >> 5) + 8 * i, c = tid & 31;
      float v = jb.src[(size_t)(kt * 64 + r) * jb.N + nt * 32 + c];
      if (jb.scale) v *= jb.scale[kt * 64 + r];
      tl[r][c] = v;
    }
    __syncthreads();
    {
      const int n = tid >> 3, k0 = (tid & 7) * 8;
      const bf16x8 o = pack8(tl[k0][n], tl[k0 + 1][n], tl[k0 + 2][n], tl[k0 + 3][n], tl[k0 + 4][n], tl[k0 + 5][n], tl[k0 + 6][n], tl[k0 + 7][n]);
      *(bf16x8*)(jb.dst + (size_t)(nt * 32 + n) * jb.K + kt * 64 + k0) = o;
    }
  }
  const int gtid = blockIdx.x * 256 + tid, gsz = gridDim.x * 256;
  {
    bfr* evin = (bfr*)(ws + OFF_EVIN);
    for (int i = gtid; i < 2 * 96 * 1024; i += gsz) { const int inst = i / (96 * 1024), r = i % (96 * 1024); evin[(size_t)inst * EVIN_NP * 1024 + (size_t)EVIN_N * 1024 + r] = 0; }
    bfr* w2 = (bfr*)(ws + OFF_W2);
    for (int i = gtid; i < 4 * 64 * 256; i += gsz) { const int inst = i / (64 * 256), r = i % (64 * 256); w2[(size_t)inst * 128 * 256 + 64 * 256 + r] = 0; }
  }
  {
    const float* x = p.in[0];
    bfr* hb = (bfr*)(ws + OFF_HB);
    float* rs = (float*)(ws + OFF_ROWSS);
    for (int row = blockIdx.x * 4 + wave; row < T; row += gridDim.x * 4) {
      float s = 0.f;
#pragma unroll
      for (int i = 0; i < 4; ++i) {
        const int c = (i * 64 + lane) * 4;
        const f32x4 v = *(const f32x4*)(x + (size_t)row * DM + c);
        s += v[0] * v[0] + v[1] * v[1] + v[2] * v[2] + v[3] * v[3];
        u32x2 o = {pk2(v[0], v[1]), pk2(v[2], v[3])};
        *(u32x2*)(hb + (size_t)row * DM + c) = o;
      }
      s += shx(s, 1); s += shx(s, 2); s += shx(s, 4); s += shx(s, 8); s += shx(s, 16); s += shx(s, 32);
      if (lane < 16) rs[(size_t)row * 16 + lane] = lane == 0 ? s : 0.f;
    }
  }
  for (int e = gtid; e < 2 * 32 * 64; e += gsz) {
    const int i = e >> 11, gp = e & 2047, g = gp >> 6;
    const float are = p.in[22][e], aim = p.in[23][e], step = expf(p.in[24][i * 32 + g]);
    const float mag = expf(are * step), ph = aim * step;
    const float lre = mag * cosf(ph), lim = mag * sinf(ph);
    float pre = lre, pim = lim;
    for (int k = 0; k < 6; ++k) { const float nr = pre * pre - pim * pim, ni = 2.f * pre * pim; pre = nr; pim = ni; }
    const float nre = lre - 1.f, nim = lim, den = are * are + aim * aim;
    const float fre = (nre * are + nim * aim) / den, fim = (nim * are - nre * aim) / den;
    float* pre_ = (float*)(ws + OFF_S5PRE) + (size_t)i * 131072;
    pre_[gp * 2] = lre; pre_[gp * 2 + 1] = lim;
    pre_[4096 + gp * 2] = pre; pre_[4096 + gp * 2 + 1] = pim;
    float* bb = pre_ + 8192 + (size_t)gp * 32;
    for (int h = 0; h < 16; ++h) {
      const float bre = p.in[25][(size_t)e * 16 + h], bim = p.in[26][(size_t)e * 16 + h];
      bb[h] = fre * bre - fim * bim; bb[16 + h] = fre * bim + fim * bre;
    }
  }
  for (int e = gtid; e < 16 * 1024; e += gsz) {
    const int sl = e >> 10, o = e & 1023, ikv = o >> 8, n = o & 255;
    const float* pe = p.in[14] + (size_t)ikv * 2048 + sl * 128;
    const float* w1 = p.in[15] + (size_t)ikv * 2048 * 256 + (size_t)sl * 128 * 256 + n;
    float acc = 0.f;
#pragma unroll 1
    for (int k0 = 0; k0 < 128; k0 += 8) {
      float wv[8], pv[8];
#pragma unroll
      for (int k = 0; k < 8; ++k) { wv[k] = w1[(size_t)(k0 + k) * 256]; pv[k] = pe[k0 + k]; }
#pragma unroll
      for (int k = 0; k < 8; ++k) acc += pv[k] * wv[k];
    }
    ((float*)(ws + OFF_B1EFF))[1024 + e] = acc;
  }
}

DI void ssd_conv_phase(const Params& p, int ei, unsigned char* smem) {
  unsigned char* ws = p.ws;
  const bfr* xraw = (const bfr*)(ws + OFF_S);
  bfr* bct = (bfr*)(ws + OFF_HB);
  bfr* xbT = (bfr*)(ws + OFF_S + 176 * MBy);
  const float* cw = p.in[8] + (size_t)ei * 4 * 1024;
  const float* cb = p.in[9] + (size_t)ei * 1024;
  const int tid = otid(), lane = tid & 63, wave = tid >> 6;
  bfr* tile = (bfr*)smem;
  const int nconv = 256 * 16;
  for (int item = blockIdx.x; item < nconv + 256; item += gridDim.x) {
    if (item < nconv) {
      const int bc = item >> 4, slab = item & 15, c = slab * 64 + lane, tq = wave;
      const int b = bc >> 7, chunk = bc & 127, t0l = chunk * 128 + tq * 32;
      const size_t tg0 = (size_t)b * L + t0l;
      const float w0 = cw[c], w1 = cw[1024 + c], w2 = cw[2048 + c], w3 = cw[3072 + c], bias = cb[c];
      float r0 = (t0l >= 3) ? bf2f(xraw[(tg0 - 3) * 1024 + c]) : 0.f;
      float r1 = (t0l >= 2) ? bf2f(xraw[(tg0 - 2) * 1024 + c]) : 0.f;
      float r2 = (t0l >= 1) ? bf2f(xraw[(tg0 - 1) * 1024 + c]) : 0.f;
      __syncthreads();
      for (int k = 0; k < 32; ++k) {
        const float r3 = bf2f(xraw[(tg0 + k) * 1024 + c]);
        const float y = siluf_(bias + w0 * r0 + w1 * r1 + w2 * r2 + w3 * r3);
        r0 = r1; r1 = r2; r2 = r3;
        const bfr yb = f2bf(y);
        if (slab >= 8) bct[(tg0 + k) * 512 + c - 512] = yb;
        if (slab < 12) tile[lane * 136 + tq * 32 + k] = yb;
      }
      __syncthreads();
      if (slab < 12) {
#pragma unroll
        for (int i = 0; i < 4; ++i) {
          const int cid = tid + 256 * i, row = cid >> 4, cc = cid & 15;
          *(u32x4*)(xbT + ((size_t)bc * 768 + slab * 64 + row) * 128 + cc * 8) = *(const u32x4*)(tile + row * 136 + cc * 8);
        }
      }
    } else {
      const int bc = item - nconv;
      const float* dtraw = (const float*)(ws + OFF_DTRAW);
      float* dtT = (float*)(ws + OFF_DTT);
      float* acum = (float*)(ws + OFF_ACUM);
      float* cdec = (float*)(ws + OFF_CDEC);
      for (int hh = 0; hh < 2; ++hh) {
        const int h = wave * 2 + hh;
        const float bias = p.in[10][ei * 8 + h], a = -expf(p.in[11][ei * 8 + h]);
        float d0 = dtraw[((size_t)bc * 128 + lane) * 8 + h] + bias, d1 = dtraw[((size_t)bc * 128 + 64 + lane) * 8 + h] + bias;
        d0 = d0 > 20.f ? d0 : log1pf(expf(d0)); d1 = d1 > 20.f ? d1 : log1pf(expf(d1));
        float s0 = d0 * a, s1 = d1 * a;
#pragma unroll
        for (int off = 1; off < 64; off <<= 1) {
          const float u0 = __shfl_up(s0, off, 64), u1 = __shfl_up(s1, off, 64);
          if (lane >= off) { s0 += u0; s1 += u1; }
        }
        const float tot0 = __shfl(s0, 63, 64);
        s1 += tot0;
        const size_t o = ((size_t)bc * 8 + h) * 128;
        dtT[o + lane] = d0; dtT[o + 64 + lane] = d1;
        acum[o + lane] = s0; acum[o + 64 + lane] = s1;
        if (lane == 63) cdec[bc * 8 + h] = expf(s1);
      }
    }
  }
}

DI void ssd_states_item(const Params& p, int witem, float* wl  ) {
  unsigned char* ws = p.ws;
  const bfr* xbT = (const bfr*)(ws + OFF_S + 176 * MBy);
  const float* dtT = (const float*)(ws + OFF_DTT);
  const float* acum = (const float*)(ws + OFF_ACUM);
  float* states = (float*)(ws + OFF_S);
  const int lane = otid() & 63, half = lane >> 5, l32 = lane & 31;
  const int bc = witem >> 3, head = witem & 7, g = head >> 2;
  const size_t o = ((size_t)bc * 8 + head) * 128;
  const float alast = acum[o + 127];
  wl[lane] = dtT[o + lane] * __expf(alast - acum[o + lane]);
  wl[64 + lane] = dtT[o + 64 + lane] * __expf(alast - acum[o + 64 + lane]);
  __builtin_amdgcn_wave_barrier();
  __builtin_amdgcn_s_waitcnt(0xc07f);
  const bfr* xrow = xbT + ((size_t)bc * 768 + head * 64) * 128;
  const bfr* brow = xbT + ((size_t)bc * 768 + 512 + g * 128) * 128;
  float* so = states + ((size_t)bc * 8 + head) * 8192;
#pragma unroll 1
  for (int nh = 0; nh < 2; ++nh) {
    f32x16 acc[2][2];
#pragma unroll
    for (int i = 0; i < 2; ++i)
#pragma unroll
      for (int j = 0; j < 2; ++j)
#pragma unroll
        for (int r = 0; r < 16; ++r) acc[i][j][r] = 0.f;
#pragma unroll 2
    for (int ks = 0; ks < 8; ++ks) {
      const int tb = ks * 16 + half * 8;
      const f32x4 s0 = *(const f32x4*)(wl + tb), s1 = *(const f32x4*)(wl + tb + 4);
      bf16x8 af[2], bq[2];
#pragma unroll
      for (int mt = 0; mt < 2; ++mt) {
        const u32x4 raw = *(const u32x4*)(xrow + (size_t)(mt * 32 + l32) * 128 + tb);
        af[mt] = pack8(bflo(raw[0]) * s0[0], bfhi(raw[0]) * s0[1], bflo(raw[1]) * s0[2], bfhi(raw[1]) * s0[3],
                       bflo(raw[2]) * s1[0], bfhi(raw[2]) * s1[1], bflo(raw[3]) * s1[2], bfhi(raw[3]) * s1[3]);
      }
#pragma unroll
      for (int nt = 0; nt < 2; ++nt) bq[nt] = ld8(brow + (size_t)((nh * 2 + nt) * 32 + l32) * 128 + tb);
#pragma unroll
      for (int mt = 0; mt < 2; ++mt)
#pragma unroll
        for (int nt = 0; nt < 2; ++nt) acc[mt][nt] = MFMA32(af[mt], bq[nt], acc[mt][nt]);
    }
#pragma unroll
    for (int mt = 0; mt < 2; ++mt)
#pragma unroll
      for (int nt = 0; nt < 2; ++nt)
#pragma unroll
        for (int i = 0; i < 16; ++i) so[(size_t)(mt * 32 + crow(i, half)) * 128 + (nh * 2 + nt) * 32 + l32] = acc[mt][nt][i];
  }
  __builtin_amdgcn_wave_barrier();
}

DI void ssd_carry_item(const Params& p, int bitem) {
  unsigned char* ws = p.ws;
  float* states = (float*)(ws + OFF_S);
  const float* cdec = (const float*)(ws + OFF_CDEC);
  const int e = bitem * 256 + otid();
  const int b = e >> 16, head = (e >> 13) & 7, pn = e & 8191;
  float run = 0.f;
#pragma unroll 1
  for (int c0 = 0; c0 < 128; c0 += 32) {
    float sv[32], dv[32];
#pragma unroll
    for (int k = 0; k < 32; ++k) {
      const int bc = b * 128 + c0 + k;
      sv[k] = states[((size_t)bc * 8 + head) * 8192 + pn];
      dv[k] = cdec[bc * 8 + head];
    }
    asm volatile("" ::: "memory"); __builtin_amdgcn_sched_barrier(0);
#pragma unroll
    for (int k = 0; k < 32; ++k) {
      const int bc = b * 128 + c0 + k;
      states[((size_t)bc * 8 + head) * 8192 + pn] = run;
      run = run * dv[k] + sv[k];
    }
  }
}

DI void ssd_out_phase(const Params& p, int ei, unsigned char* smem) {
  unsigned char* ws = p.ws;
  const bfr* xbT = (const bfr*)(ws + OFF_S + 176 * MBy);
  const bfr* bct = (const bfr*)(ws + OFF_HB);
  const bfr* zb = (const bfr*)(ws + OFF_S + 64 * MBy);
  const float* dtT = (const float*)(ws + OFF_DTT);
  const float* acum = (const float*)(ws + OFF_ACUM);
  const float* states = (const float*)(ws + OFF_S);
  bfr* mix = (bfr*)(ws + OFF_MIX);
  const int tid = otid(), lane = tid & 63, wave = tid >> 6, half = lane >> 5, l32 = lane & 31;
  float* wac = (float*)smem + wave * 256;
  float* ssq = (float*)smem + 1024;
  for (int item = blockIdx.x; item < 512; item += gridDim.x) {
    const int bc = item >> 1, g = item & 1, head = g * 4 + wave;
    const size_t tg0 = (size_t)bc * 128;
    const size_t o = ((size_t)bc * 8 + head) * 128;
    __syncthreads();
    wac[lane] = acum[o + lane]; wac[64 + lane] = acum[o + 64 + lane];
    wac[128 + lane] = dtT[o + lane]; wac[192 + lane] = dtT[o + 64 + lane];
    __syncthreads();
    const bfr* Cm = bct + tg0 * 512 + 256 + g * 128;
    const bfr* Bm = bct + tg0 * 512 + g * 128;
    const float* hin = states + ((size_t)bc * 8 + head) * 8192;
    const bfr* xrow = xbT + ((size_t)bc * 768 + head * 64) * 128;
    const float dsk = p.in[12][ei * 8 + head];
    const float* ng = p.in[13] + (size_t)ei * 512 + head * 64;
    const float g0 = ng[l32], g1 = ng[32 + l32];
#pragma unroll 1
    for (int tt = 0; tt < 4; ++tt) {
      f32x16 Y0, Y1;
#pragma unroll
      for (int r = 0; r < 16; ++r) { Y0[r] = 0.f; Y1[r] = 0.f; }
#pragma unroll 2
      for (int ks = 0; ks < 8; ++ks) {
        const int nb = ks * 16 + half * 8;
        const bf16x8 cf = ld8(Cm + (size_t)(tt * 32 + l32) * 512 + nb);
        const float* hp0 = hin + (size_t)l32 * 128 + nb;
        const float* hp1 = hp0 + 32 * 128;
        const f32x4 a0 = *(const f32x4*)hp0, a1 = *(const f32x4*)(hp0 + 4), b0 = *(const f32x4*)hp1, b1 = *(const f32x4*)(hp1 + 4);
        Y0 = MFMA32(cf, pack8(a0[0], a0[1], a0[2], a0[3], a1[0], a1[1], a1[2], a1[3]), Y0);
        Y1 = MFMA32(cf, pack8(b0[0], b0[1], b0[2], b0[3], b1[0], b1[1], b1[2], b1[3]), Y1);
      }
#pragma unroll
      for (int i = 0; i < 16; ++i) {
        const float e = __expf(wac[tt * 32 + crow(i, half)]);
        Y0[i] *= e; Y1[i] *= e;
      }
      const float at = wac[tt * 32 + l32];
      const int tl = tt * 32 + l32;
#pragma unroll 1
      for (int st = 0; st <= tt; ++st) {
        f32x16 X;
#pragma unroll
        for (int r = 0; r < 16; ++r) X[r] = 0.f;
#pragma unroll 2
        for (int ks = 0; ks < 8; ++ks) {
          const int nb = ks * 16 + half * 8;
          const bf16x8 bfm = ld8(Bm + (size_t)(st * 32 + l32) * 512 + nb);
          const bf16x8 cfm = ld8(Cm + (size_t)(tt * 32 + l32) * 512 + nb);
          X = MFMA32(bfm, cfm, X);
        }
#pragma unroll
        for (int i = 0; i < 16; ++i) {
          const int s_ = st * 32 + crow(i, half);
          const float f = (s_ <= tl) ? __expf(at - wac[s_]) * wac[128 + s_] : 0.f;
          X[i] *= f;
        }
#pragma unroll
        for (int k2 = 0; k2 < 2; ++k2) {
          const bf16x8 pa = pack8(X[8 * k2], X[8 * k2 + 1], X[8 * k2 + 2], X[8 * k2 + 3], X[8 * k2 + 4], X[8 * k2 + 5], X[8 * k2 + 6], X[8 * k2 + 7]);
          const bfr* xp = xrow + (size_t)l32 * 128 + st * 32 + 16 * k2 + 4 * half;
          const u32x2 lo0 = *(const u32x2*)xp, hi0 = *(const u32x2*)(xp + 8);
          const u32x2 lo1 = *(const u32x2*)(xp + 32 * 128), hi1 = *(const u32x2*)(xp + 32 * 128 + 8);
          const u32x4 xv0 = {lo0[0], lo0[1], hi0[0], hi0[1]}, xv1 = {lo1[0], lo1[1], hi1[0], hi1[1]};
          Y0 = MFMA32(pa, __builtin_bit_cast(bf16x8, xv0), Y0);
          Y1 = MFMA32(pa, __builtin_bit_cast(bf16x8, xv1), Y1);
        }
      }
#pragma unroll
      for (int q = 0; q < 4; ++q) {
        const bfr* xq = xrow + (size_t)l32 * 128 + tt * 32 + 8 * q + 4 * half;
        const u32x2 xa = *(const u32x2*)xq, xb = *(const u32x2*)(xq + 32 * 128);
        const float xs0[4] = {bflo(xa[0]), bfhi(xa[0]), bflo(xa[1]), bfhi(xa[1])};
        const float xs1[4] = {bflo(xb[0]), bfhi(xb[0]), bflo(xb[1]), bfhi(xb[1])};
#pragma unroll
        for (int j = 0; j < 4; ++j) {
          const int i = q * 4 + j;
          const int t = tt * 32 + 8 * q + 4 * half + j;
          const bfr* zp = zb + (tg0 + t) * 512 + head * 64 + l32;
          Y0[i] = (Y0[i] + dsk * xs0[j]) * siluf_(bf2f(zp[0]));
          Y1[i] = (Y1[i] + dsk * xs1[j]) * siluf_(bf2f(zp[32]));
        }
      }
#pragma unroll
      for (int i = 0; i < 16; ++i) {
        float s_ = Y0[i] * Y0[i] + Y1[i] * Y1[i];
        s_ += shx(s_, 1); s_ += shx(s_, 2); s_ += shx(s_, 4); s_ += shx(s_, 8); s_ += shx(s_, 16);
        if (l32 == 0) ssq[wave * 32 + crow(i, half)] = s_;
      }
      __syncthreads();
#pragma unroll
      for (int i = 0; i < 16; ++i) {
        const int rr = crow(i, half), t = tt * 32 + rr;
        const float tot = ssq[rr] + ssq[32 + rr] + ssq[64 + rr] + ssq[96 + rr];
        const float rs = rsqrtf(tot * (1.f / 256.f) + EPS);
        bfr* mp = mix + (tg0 + t) * DM + head * 64;
        mp[l32] = f2bf(Y0[i] * rs * g0);
        mp[32 + l32] = f2bf(Y1[i] * rs * g1);
      }
      __syncthreads();
    }
  }
}

struct AttnSt { float m, l; f32x4 o[4]; };
DI void attn_init(AttnSt& s, float m0, float l0) {
  s.m = m0; s.l = l0;
#pragma unroll
  for (int i = 0; i < 4; ++i) s.o[i] = (f32x4){0.f, 0.f, 0.f, 0.f};
}
DI void attn_scores(const bfr* Kp, int key0, const bf16x8& q0, const bf16x8& q1, int r, int quad, float* sc) {
  const bfr* kr = Kp + (size_t)key0 * 64 + (quad * 16 + r) * 8;
  const bf16x8 a00 = ld8(kr), a01 = ld8(kr + 512), a10 = ld8(kr + 1024), a11 = ld8(kr + 1536);
  f32x4 s0 = {0.f, 0.f, 0.f, 0.f}, s1 = {0.f, 0.f, 0.f, 0.f};
  s0 = MFMA16(a00, q0, s0); s0 = MFMA16(a01, q1, s0);
  s1 = MFMA16(a10, q0, s1); s1 = MFMA16(a11, q1, s1);
#pragma unroll
  for (int i = 0; i < 4; ++i) { sc[i] = s0[i]; sc[4 + i] = s1[i]; }
}
DI void attn_pv(AttnSt& s, const bfr* VTp, int key0, const bf16x8& pb, int r, int quad) {
  const bfr* vb = VTp + (size_t)key0 * 64 + (quad * 16 + r) * 8;
#pragma unroll
  for (int dt = 0; dt < 4; ++dt) s.o[dt] = MFMA16(ld8(vb + dt * 512), pb, s.o[dt]);
}
DI float attn_finish_l(const AttnSt& s) { float l = swadd16(s.l); l = swadd32(l); return l; }
DI void load_q(const bfr* qn, size_t t0, int hbase, int lane, bf16x8& q0, bf16x8& q1) {
  const int r = lane & 15, quad = lane >> 4;
  const bfr* qp = qn + (t0 + (r >> 2)) * 512 + (hbase + (r & 3)) * 64 + quad * 8;
  q0 = ld8(qp); q1 = ld8(qp + 32);
}

struct KV32 { bf16x8 k[4]; bf16x8 v[4]; };
struct UnitD { const bfr* Kp; const bfr* VTp; int key0, hi, lo; bool fast, colok; };
DI void load_kv32(KV32& r, const UnitD& d, int rr, int quad) {
  const size_t off = (size_t)d.key0 * 64 + (quad * 16 + rr) * 8;
  const bfr* kr = d.Kp + off;
  const bfr* vb = d.VTp + off;
#pragma unroll
  for (int i = 0; i < 4; ++i) { r.k[i] = ld8(kr + i * 512); r.v[i] = ld8(vb + i * 512); }
}
template <int MODE>
DI void attn_step32(AttnSt& s, const KV32& kv, const bf16x8& q0, const bf16x8& q1, const UnitD& d, int quad) {
  f32x4 s0 = {0.f, 0.f, 0.f, 0.f}, s1 = {0.f, 0.f, 0.f, 0.f};
  s0 = MFMA16(kv.k[0], q0, s0); s0 = MFMA16(kv.k[1], q1, s0);
  s1 = MFMA16(kv.k[2], q0, s1); s1 = MFMA16(kv.k[3], q1, s1);
  float sc[8];
  float lm = -3e38f;
#pragma unroll
  for (int i = 0; i < 8; ++i) {
    float v = (i < 4 ? s0[i & 3] : s1[i & 3]);
    if (MODE == 0) { const int key = d.key0 + (i >> 2) * 16 + quad * 4 + (i & 3); v = (key <= d.hi && key >= d.lo) ? v : -3e38f; }
    sc[i] = v; lm = fmaxf(lm, v);
  }
  if (MODE == 1) lm = d.colok ? lm : -3e38f;
  if (__builtin_amdgcn_ballot_w64(lm > s.m + 8.f) != 0ull) {
    float mt = swmax16(lm); mt = swmax32(mt);
    const float mn = fmaxf(s.m, mt);
    const float alpha = ex2(s.m - mn);
    s.l *= alpha; s.m = mn;
#pragma unroll
    for (int dt = 0; dt < 4; ++dt) s.o[dt] *= alpha;
  }
  const float meff = (MODE == 1) ? (d.colok ? s.m : 1e30f) : s.m;
  float ps = 0.f;
#pragma unroll
  for (int i = 0; i < 8; ++i) { sc[i] = ex2(sc[i] - meff); ps += sc[i]; }
  s.l += ps;
  const bf16x8 pb = pack8(sc[0], sc[1], sc[2], sc[3], sc[4], sc[5], sc[6], sc[7]);
#pragma unroll
  for (int dt = 0; dt < 4; ++dt) s.o[dt] = MFMA16(kv.v[dt], pb, s.o[dt]);
}
#define PIN_LOADS() do { asm volatile("" ::: "memory"); __builtin_amdgcn_sched_barrier(0); } while (0)
template <class UF>
DI void attn_stream(AttnSt& s, int n, const UF& uf, const bf16x8& q0, const bf16x8& q1, int lane) {
  const int rr = lane & 15, quad = lane >> 4;
  if (n <= 0) return;
  KV32 a, b;
  { const UnitD d = uf(0); load_kv32(a, d, rr, quad); }
  PIN_LOADS();
#pragma unroll 1
  for (int u = 0; u < n; u += 2) {
    { const UnitD dn = uf(u + 1 < n ? u + 1 : n - 1); load_kv32(b, dn, rr, quad); }
    PIN_LOADS();
    { const UnitD d = uf(u); if (d.fast) attn_step32<1>(s, a, q0, q1, d, quad); else attn_step32<0>(s, a, q0, q1, d, quad); }
    PIN_LOADS();
    { const UnitD dn = uf(u + 2 < n ? u + 2 : n - 1); load_kv32(a, dn, rr, quad); }
    PIN_LOADS();
    if (u + 1 < n) { const UnitD d = uf(u + 1); if (d.fast) attn_step32<1>(s, b, q0, q1, d, quad); else attn_step32<0>(s, b, q0, q1, d, quad); }
    PIN_LOADS();
  }
}

DI void swa_item(const Params& p, int oi, int witem) {
  unsigned char* ws = p.ws;
  const bfr* qn = (const bfr*)(ws + OFF_S + 96 * MBy);
  const bfr* ksw = (const bfr*)(ws + OFF_S + 128 * MBy);
  const bfr* vswT = (const bfr*)(ws + OFF_S + 136 * MBy);
  bfr* mix = (bfr*)(ws + OFF_MIX);
  const int lane = otid() & 63, r = lane & 15, quad = lane >> 4;
  const int bg = witem >> 12, qd = witem & 4095, b = bg >> 1, g = bg & 1, t0 = qd * 4;
  bf16x8 q0, q1;
  load_q(qn, (size_t)b * L + t0, g * 4, lane, q0, q1);
  const int tq = t0 + (r >> 2), lo = tq - 127 > 0 ? tq - 127 : 0;
  const float sink = p.in[21][oi * 8 + g * 4 + (r & 3)];
  AttnSt s;
  attn_init(s, sink * LOG2E, quad == 0 ? 1.f : 0.f);
  const bfr* Kp = ksw + (size_t)bg * L * 64;
  const bfr* VTp = vswT + (size_t)bg * 256 * 4096;
  {
    int ks = t0 - 127; ks = ks < 0 ? 0 : (ks & ~31);
    const int n = ((t0 + 3) >> 5) - (ks >> 5) + 1;
    const int lomax = t0 + 3 - 127;
    auto uf = [&](int u) { UnitD d; d.Kp = Kp; d.VTp = VTp; d.key0 = ks + 32 * u; d.hi = tq; d.lo = lo; d.fast = (d.key0 >= lomax) && (d.key0 + 31 <= t0); d.colok = true; return d; };
    attn_stream(s, n, uf, q0, q1, lane);
  }
  const float l = attn_finish_l(s), inv = 1.f / l;
  bfr* mp = mix + ((size_t)b * L + tq) * DM + (g * 4 + (r & 3)) * 64 + quad * 4;
#pragma unroll
  for (int dt = 0; dt < 4; ++dt) {
    u32x2 o = {pk2(s.o[dt][0] * inv, s.o[dt][1] * inv), pk2(s.o[dt][2] * inv, s.o[dt][3] * inv)};
    *(u32x2*)(mp + dt * 16) = o;
  }
}

DI void nsa_item(const Params& p, int witem, float* wl) {
  unsigned char* ws = p.ws;
  const bfr* qn = (const bfr*)(ws + OFF_S + 96 * MBy);
  const bfr* parts = (const bfr*)(ws + OFF_S + 128 * MBy);
  const bfr* kc = (const bfr*)(ws + OFF_KC);
  const bfr* vcT = (const bfr*)(ws + OFF_VCT);
  const float* gates = (const float*)(ws + OFF_GATES);
  bfr* mix = (bfr*)(ws + OFF_MIX);
  float* own4 = wl; float* lastp = wl + 1024; int* sel = (int*)(wl + 2048);
  const int lane = otid() & 63, r = lane & 15, quad = lane >> 4;
  const int bg = witem >> 12, qd = witem & 4095, b = bg >> 1, g = bg & 1, t0 = qd * 4;
  bf16x8 q0, q1;
  load_q(qn, (size_t)b * L + t0, g * 4, lane, q0, q1);
  const int tok = r >> 2, tq = t0 + tok;
  float* resl = wl + 2176;
  const float* gp = gates + ((size_t)b * L + tq) * 24 + g * 12 + (r & 3) * 3;
  const float g_cmp = gp[0], g_slc = gp[1], g_win = gp[2];
  for (int rp = 0; rp < ((NSAREP & 1) ? 2 : 1); ++rp) {
    const bfr* Kp = kc + (size_t)bg * 1024 * 64;
    const bfr* VTp = vcT + (size_t)bg * 16 * 4096;
    const int hi = tq >= 31 ? ((tq - 31) >> 4) : -1;
    const int tmax = t0 + 3, nmax = tmax >= 31 ? ((tmax - 31) >> 4) : -1;
    float m = NEGF, lsum = 0.f;
    for (int k0 = 0; k0 <= nmax; k0 += 32) {
      float sc[8];
      attn_scores(Kp, k0, q0, q1, r, quad, sc);
      float mt = NEGF;
#pragma unroll
      for (int i = 0; i < 8; ++i) { const int key = k0 + (i >> 2) * 16 + quad * 4 + (i & 3); sc[i] = key <= hi ? sc[i] : NEGF; mt = fmaxf(mt, sc[i]); }
      mt = swmax16(mt); mt = swmax32(mt);
      const float mn = fmaxf(m, mt);
      float ps = 0.f;
#pragma unroll
      for (int i = 0; i < 8; ++i) { const int key = k0 + (i >> 2) * 16 + quad * 4 + (i & 3); ps += key <= hi ? ex2(sc[i] - mn) : 0.f; }
      lsum = lsum * ex2(m - mn) + ps; m = mn;
    }
    lsum = swadd16(lsum); lsum = swadd32(lsum);
    const float inv = lsum > 0.f ? 1.f / lsum : 0.f;
    AttnSt s; attn_init(s, m, 0.f);
    for (int k0 = 0; k0 <= nmax; k0 += 32) {
      float sc[8];
      attn_scores(Kp, k0, q0, q1, r, quad, sc);
#pragma unroll
      for (int i = 0; i < 8; ++i) { const int key = k0 + (i >> 2) * 16 + quad * 4 + (i & 3); sc[i] = key <= hi ? ex2(sc[i] - m) * inv : 0.f; }
      const bf16x8 pb = pack8(sc[0], sc[1], sc[2], sc[3], sc[4], sc[5], sc[6], sc[7]);
      attn_pv(s, VTp, k0, pb, r, quad);
#pragma unroll
      for (int i = 0; i < 8; ++i) { sc[i] += xor1(sc[i]); sc[i] += xor2(sc[i]); }
      if ((r & 3) == 0) {
        const int j0 = (k0 >> 2) + quad;
        own4[tok * 256 + j0] = sc[0] + sc[1] + sc[2] + sc[3]; lastp[tok * 256 + j0] = sc[3];
        own4[tok * 256 + j0 + 4] = sc[4] + sc[5] + sc[6] + sc[7]; lastp[tok * 256 + j0 + 4] = sc[7];
      }
    }
#pragma unroll
    for (int dt = 0; dt < 4; ++dt)
#pragma unroll
      for (int i = 0; i < 4; ++i) resl[(dt * 4 + i) * 64 + lane] = s.o[dt][i] * g_cmp;
  }
  __builtin_amdgcn_wave_barrier();
  __builtin_amdgcn_s_waitcnt(0xc07f);
  for (int rp = 0; rp < ((NSAREP & 2) ? 2 : 1); ++rp) {
    const int cur = t0 >> 6;
    if (cur < 16) {
      sel[lane] = (lane & 15) + 1;
    } else {
#pragma unroll 1
      for (int tk = 0; tk < 4; ++tk) {
        unsigned u[4];
#pragma unroll
        for (int c = 0; c < 4; ++c) {
          const int j = lane + 64 * c;
          const bool forced = (j == 0) || (j == cur) || (j == cur - 1);
          float v = -1e9f;
          if (j <= cur) { v = own4[tk * 256 + j]; if (j > 0) v += lastp[tk * 256 + j - 1]; }
          const unsigned bb = __float_as_uint(v);
          u[c] = forced ? 0u : ((bb & 0x80000000u) ? ~bb : (bb | 0x80000000u));
        }
        unsigned prefix = 0u;
#pragma unroll 1
        for (int bit = 31; bit >= 0; --bit) {
          const unsigned trial = prefix | (1u << bit);
          int cnt = 0;
#pragma unroll
          for (int c = 0; c < 4; ++c) cnt += __builtin_popcountll(__builtin_amdgcn_ballot_w64(u[c] >= trial));
          if (cnt >= 13) prefix = trial;
        }
        int ngt = 0;
        unsigned long long mgt[4], meq[4];
#pragma unroll
        for (int c = 0; c < 4; ++c) { mgt[c] = __builtin_amdgcn_ballot_w64(u[c] > prefix); meq[c] = __builtin_amdgcn_ballot_w64(u[c] == prefix); ngt += __builtin_popcountll(mgt[c]); }
        const int need = 13 - ngt;
        int eqbase = 0, pos = 0;
#pragma unroll
        for (int c = 0; c < 4; ++c) {
          const int below_eq = __builtin_amdgcn_mbcnt_hi((unsigned)(meq[c] >> 32), __builtin_amdgcn_mbcnt_lo((unsigned)meq[c], 0u));
          const bool take = (u[c] > prefix) || ((u[c] == prefix) && (eqbase + below_eq < need));
          const unsigned long long mt = __builtin_amdgcn_ballot_w64(take);
          const int below = __builtin_amdgcn_mbcnt_hi((unsigned)(mt >> 32), __builtin_amdgcn_mbcnt_lo((unsigned)mt, 0u));
          if (take) sel[tk * 16 + pos + below] = lane + 64 * c;
          pos += __builtin_popcountll(mt);
          eqbase += __builtin_popcountll(meq[c]);
        }
      }
    }
  }
  __builtin_amdgcn_wave_barrier();
  __builtin_amdgcn_s_waitcnt(0xc07f);
  for (int rp = 0; rp < ((NSAREP & 4) ? 2 : 1); ++rp) {
    const bfr* Kp = parts + (size_t)2 * (4u * MBy) + (size_t)bg * L * 64;
    const bfr* VTp = parts + (size_t)3 * (4u * MBy) + (size_t)bg * 256 * 4096;
    AttnSt s; attn_init(s, NEGF, 0.f);
    {
      const int selv = sel[lane];
      const int cur = t0 >> 6;
      const int nnf = cur >= 16 ? 13 : (cur >= 2 ? cur - 2 : 0);
      const int nf = cur >= 2 ? 3 : cur + 1;
      auto uf = [&](int u) {
        UnitD d; d.Kp = Kp; d.VTp = VTp; d.lo = 0;
        if (u < 2 * nf) {
          const int fi = u >> 1, j = (fi == 0) ? 0 : (nf == 2 ? 1 : (fi == 1 ? cur - 1 : cur));
          d.key0 = j * 64 + (u & 1) * 32; d.colok = true; d.hi = tq; d.fast = j < cur;
        } else {
          const int v = u - 2 * nf, tk = v / (2 * nnf), rem = v - tk * 2 * nnf, k = rem >> 1;
          const int j = __builtin_amdgcn_readlane(selv, tk * 16 + k);
          d.key0 = j * 64 + (rem & 1) * 32; d.colok = (tok == tk); d.hi = d.colok ? t0 + tk : -1; d.fast = true;
        }
        return d; };
      attn_stream(s, 2 * nf + 8 * nnf, uf, q0, q1, lane);
    }
    const float l = attn_finish_l(s), inv = (l > 0.f ? g_slc / l : 0.f) * (rp == 0 ? 1.f : 1e-30f);
#pragma unroll
    for (int dt = 0; dt < 4; ++dt)
#pragma unroll
      for (int i = 0; i < 4; ++i) resl[(dt * 4 + i) * 64 + lane] += s.o[dt][i] * inv;
  }
  {
    const bfr* Kp = parts + (size_t)4 * (4u * MBy) + (size_t)bg * L * 64;
    const bfr* VTp = parts + (size_t)5 * (4u * MBy) + (size_t)bg * 256 * 4096;
    AttnSt s; attn_init(s, NEGF, 0.f);
    const int lo = tq - 511 > 0 ? tq - 511 : 0;
    int ks = t0 - 511; ks = ks < 0 ? 0 : (ks & ~31);
    const int n = ((t0 + 3) >> 5) - (ks >> 5) + 1;
    const int lomax = t0 + 3 - 511;
    auto uf = [&](int u) { UnitD d; d.Kp = Kp; d.VTp = VTp; d.key0 = ks + 32 * u; d.hi = tq; d.lo = lo; d.fast = (d.key0 >= lomax) && (d.key0 + 31 <= t0); d.colok = true; return d; };
    attn_stream(s, n, uf, q0, q1, lane);
    const float l = attn_finish_l(s), inv = l > 0.f ? g_win / l : 0.f;
#pragma unroll
    for (int dt = 0; dt < 4; ++dt) {
      f32x4 r4;
#pragma unroll
      for (int i = 0; i < 4; ++i) r4[i] = resl[(dt * 4 + i) * 64 + lane] + s.o[dt][i] * inv;
      s.o[dt] = r4;
    }
    bfr* mp = mix + ((size_t)b * L + tq) * DM + 512 + (g * 4 + (r & 3)) * 64 + quad * 4;
#pragma unroll
    for (int dt = 0; dt < 4; ++dt) *(u32x2*)(mp + dt * 16) = pk4(s.o[dt]);
  }
  __builtin_amdgcn_wave_barrier();
}

template <bool PASSB>
DI void s5_item(const Params& p, int oi, int witem, float* wl  ) {
  unsigned char* ws = p.ws;
  const float* us5 = (const float*)(ws + OFF_S);
  bfr* yg = (bfr*)(ws + OFF_S + 64 * MBy);
  float* S = (float*)(ws + OFF_S5S);
  const float* pre = (const float*)(ws + OFF_S5PRE) + (size_t)oi * 131072;
  const int lane = otid() & 63;
  const int bgi = witem >> 8, c = witem & 255, b = bgi >> 5, g = bgi & 31;
  const int gp = g * 64 + lane;
  const float lre = pre[gp * 2], lim = pre[gp * 2 + 1];
  float bre[16], bim[16];
#pragma unroll
  for (int h = 0; h < 16; ++h) { bre[h] = pre[8192 + gp * 32 + h]; bim[h] = pre[8192 + gp * 32 + 16 + h]; }
  const size_t tg0 = (size_t)b * L + c * 64;
  __builtin_amdgcn_wave_barrier();
#pragma unroll
  for (int i = 0; i < 4; ++i) {
    const int idx = i * 64 + lane, tt = idx >> 2, q = idx & 3;
    *(f32x4*)(wl + tt * 16 + q * 4) = *(const f32x4*)(us5 + (tg0 + tt) * 512 + g * 16 + q * 4);
  }
  __builtin_amdgcn_wave_barrier();
  __builtin_amdgcn_s_waitcnt(0xc07f);
  float xre = 0.f, xim = 0.f;
  if (PASSB) {
    const float Lre = pre[4096 + gp * 2], Lim = pre[4096 + gp * 2 + 1];
    const float* Sp = S + (size_t)bgi * 256 * 128;
    int cc = 0;
    for (; cc + 8 <= c; cc += 8) {
      float sr[8], si[8];
#pragma unroll
      for (int k = 0; k < 8; ++k) { sr[k] = Sp[(cc + k) * 128 + lane]; si[k] = Sp[(cc + k) * 128 + 64 + lane]; }
      asm volatile("" ::: "memory"); __builtin_amdgcn_sched_barrier(0);
#pragma unroll
      for (int k = 0; k < 8; ++k) { const float nr = Lre * xre - Lim * xim + sr[k], ni = Lre * xim + Lim * xre + si[k]; xre = nr; xim = ni; }
    }
    for (; cc < c; ++cc) {
      const float sr = Sp[cc * 128 + lane], si = Sp[cc * 128 + 64 + lane];
      const float nr = Lre * xre - Lim * xim + sr, ni = Lre * xim + Lim * xre + si;
      xre = nr; xim = ni;
    }
  }
  const int r16 = lane & 15, quad = lane >> 4;
  bf16x8 cf[4];
  f32x4 dsk4 = {0.f, 0.f, 0.f, 0.f};
  bfr* xl = (bfr*)(wl + 1024);
  if (PASSB) {
    const float* cr = p.in[27] + ((size_t)oi * 32 + g) * 16 * 64 + r16 * 64;
    const float* ci = p.in[28] + ((size_t)oi * 32 + g) * 16 * 64 + r16 * 64;
#pragma unroll
    for (int ks = 0; ks < 4; ++ks) {
      const float* src = (ks < 2 ? cr : ci) + (ks & 1) * 32 + quad * 8;
      const f32x4 a0 = *(const f32x4*)src, a1 = *(const f32x4*)(src + 4);
      const float sg = ks < 2 ? 1.f : -1.f;
      cf[ks] = pack8(sg * a0[0], sg * a0[1], sg * a0[2], sg * a0[3], sg * a1[0], sg * a1[1], sg * a1[2], sg * a1[3]);
    }
    dsk4 = *(const f32x4*)(p.in[29] + (size_t)oi * 512 + g * 16 + quad * 4);
  }
#pragma unroll 1
  for (int tb = 0; tb < 4; ++tb) {
#pragma unroll 2
    for (int t16 = 0; t16 < 16; ++t16) {
      const int tt = tb * 16 + t16;
      float u[16];
#pragma unroll
      for (int q = 0; q < 4; ++q) { const f32x4 v = *(const f32x4*)(wl + tt * 16 + q * 4); u[q * 4] = v[0]; u[q * 4 + 1] = v[1]; u[q * 4 + 2] = v[2]; u[q * 4 + 3] = v[3]; }
      float ar0 = 0.f, ar1 = 0.f, ai0 = 0.f, ai1 = 0.f;
#pragma unroll
      for (int h = 0; h < 16; h += 2) { ar0 += bre[h] * u[h]; ar1 += bre[h + 1] * u[h + 1]; ai0 += bim[h] * u[h]; ai1 += bim[h + 1] * u[h + 1]; }
      const float ar = ar0 + ar1, ai = ai0 + ai1;
      const float nr = lre * xre - lim * xim + ar, ni = lre * xim + lim * xre + ai;
      xre = nr; xim = ni;
      if (PASSB) { xl[t16 * 136 + lane] = f2bf(xre); xl[t16 * 136 + 64 + lane] = f2bf(xim); }
    }
    if (PASSB) {
      __builtin_amdgcn_wave_barrier();
      f32x4 y = {0.f, 0.f, 0.f, 0.f};
#pragma unroll
      for (int ks = 0; ks < 4; ++ks) y = MFMA16(cf[ks], *(const bf16x8*)(xl + r16 * 136 + ks * 32 + quad * 8), y);
      const int t = tb * 16 + r16;
      const f32x4 uu = *(const f32x4*)(wl + t * 16 + quad * 4);
      f32x4 o;
#pragma unroll
      for (int i = 0; i < 4; ++i) o[i] = gelu_tanh(y[i] + dsk4[i] * uu[i]);
      *(u32x2*)(yg + (tg0 + t) * 512 + g * 16 + quad * 4) = pk4(o);
      __builtin_amdgcn_wave_barrier();
    }
  }
  if (!PASSB) {
    float* Sp = S + ((size_t)bgi * 256 + c) * 128;
    Sp[lane] = xre; Sp[64 + lane] = xim;
  }
  __builtin_amdgcn_wave_barrier();
}

__global__ void __launch_bounds__(256, 2) fwd_mega(Params p) {
  __shared__ __attribute__((aligned(16))) unsigned char smem[56832];
  cg::grid_group grid = cg::this_grid();
  unsigned char* ws = p.ws;
  const int tid = threadIdx.x, wave = __builtin_amdgcn_readfirstlane(tid >> 6);
  float* rowss = (float*)(ws + OFF_ROWSS);
  bfr* hb = (bfr*)(ws + OFF_HB);
  bfr* mixb = (bfr*)(ws + OFF_MIX);
  __shared__ __attribute__((aligned(16))) unsigned xbw[4];
  __shared__ int xmw[4];
  if (tid == 0) { xbw[0] = 0u; xbw[1] = 0u; xbw[2] = 0u; xbw[3] = 0u; }
  __syncthreads();
  XcdBarrier xb; xb.bar = (unsigned*)(ws + OFF_BAR); xb.x = xb_xcc_id(); xb.st = (volatile LAS unsigned*)xbw;
  unsigned myloc = 0;
  if (tid == 0) myloc = xb_add(&xb.bar[XB_XCNT(xb.x)], 1u);
  for (int rep = 0; rep < (((REPMASK >> 15) & 1) ? 2 : 1); ++rep) {
  if (PHMASK & 1) prep_phase(p, smem);
  if (p.njobs < 0) grid.sync();
  xcd_barrier(xb);
  }
  if (tid == 0) {
    unsigned cnt[8], sum = 0, okf = 1;
    for (int j = 0; j < 8; ++j) { cnt[j] = xb_ld(&xb.bar[XB_XCNT(j)]); sum += cnt[j]; okf &= (cnt[j] > 0u) ? 1u : 0u; }
    okf &= (sum == gridDim.x) ? 1u : 0u; okf &= (xb.x < 8u) ? 1u : 0u;
    xmw[0] = (int)okf; xmw[1] = (int)xb.x; xmw[2] = (int)myloc; xmw[3] = (int)(xb.x < 8u ? cnt[xb.x] : 1u);
  }
  __syncthreads();
  XMap xm; xm.ok = xmw[0]; xm.xcd = xmw[1]; xm.loc = xmw[2]; xm.nloc = xmw[3];
  if (blockIdx.x == 0) {
    float* be = (float*)(ws + OFF_B1EFF);
    for (int o = tid; o < 1024; o += 256) { float sm = p.in[16][o]; for (int sl = 0; sl < 16; ++sl) sm += be[1024 + sl * 1024 + o]; be[o] = sm; }
  }
#pragma unroll 1
  for (int layer = 0; layer < 4; ++layer) {
    const int li = layer >> 1;
    const bool even = (layer & 1) == 0;
    const float* hin = layer == 0 ? p.in[0] : p.out;
    const int nst = even ? 8 : 7;
#pragma unroll 1
    for (int step = 0; step < nst; ++step) {
      GemmDesc d;
      d.kind = -1; d.rpart = nullptr; d.sA = 0; d.sB = 0; d.nbatch = 1;
      const int gk = even ? step : (step == 0 ? 8 : (step < 3 ? 8 + step : step + 1 + 6));
      const int code = even ? step : (step <= 2 ? 8 + step : (step == 3 ? 11 : (step == 4 ? 5 : step + 1)));
      (void)gk;
      const int nrep = ((REPMASK >> code) & 1) ? 2 : 1;
      for (int rep = 0; rep < nrep; ++rep) {
      switch (code) {
        case 0: {
          d.kind = 0; d.A = hb; d.lda = DM; d.Bt = (const bfr*)(ws + OFF_EVIN) + (size_t)li * EVIN_NP * 1024; d.ldb = 1024; d.M = T; d.N = EVIN_NP; d.K = 1024; d.rpart = rowss;
          d.e0 = EpiEvenIn{ws};
        } break;
        case 1: {
          if (PHMASK & 2) ssd_conv_phase(p, li, smem);
          d.kind = 5; d.A = (const bfr*)(ws + OFF_S + 128 * MBy); d.lda = 1024; d.sA = (size_t)4096 * 1024; d.Bt = (const bfr*)(ws + OFF_W1) + (size_t)li * 2 * 256 * 2048; d.ldb = 2048;
          d.sB = (size_t)256 * 2048; d.M = 4096; d.N = 256; d.K = 2048; d.nbatch = 2;
          d.e5 = EpiW1{ws, li};
        } break;
        case 2: {
          if (PHMASK & 4) for (int it = blockIdx.x; it < 512; it += gridDim.x) ssd_states_item(p, it * 4 + wave, (float*)smem + wave * 128);
          d.kind = 6; d.A = (const bfr*)(ws + OFF_NSAHID); d.lda = 256; d.sA = (size_t)4096 * 256; d.Bt = (const bfr*)(ws + OFF_W2) + (size_t)li * 2 * 128 * 256; d.ldb = 256;
          d.sB = (size_t)128 * 256; d.M = 4096; d.N = 128; d.K = 256; d.nbatch = 2;
          d.e6 = EpiW2{ws, p.in[18] + li * 128};
        } break;
        case 3: {
          if (rep == 0) for (int it = blockIdx.x; it < 512; it += gridDim.x) { if (PHMASK & 8) ssd_carry_item(p, it); }
          if (xm.ok) {
            const int bg = xm.xcd >> 1, sub = xm.xcd & 1;
            for (int k = xm.loc; k < 512; k += xm.nloc) { if (PHMASK & 16) nsa_item(p, bg * 4096 + (2 * k + sub) * 4 + wave, (float*)smem + wave * 3200); }
          } else {
            for (int it = blockIdx.x; it < 4096; it += gridDim.x) { if (PHMASK & 16) nsa_item(p, it * 4 + wave, (float*)smem + wave * 3200); }
          }
        } break;
        case 4: { if (PHMASK & 32) ssd_out_phase(p, li, smem); } break;
        case 5: {
          d.kind = 2; d.A = mixb; d.lda = DM; d.Bt = (even ? (const bfr*)(ws + OFF_EVOUT) : (const bfr*)(ws + OFF_ODOUT)) + (size_t)li * 1024 * 1024; d.ldb = 1024; d.M = T; d.N = 1024; d.K = 1024;
          d.e2 = EpiRes{hin, p.out, hb, rowss + (size_t)T * 16};
        } break;
        case 6: {
          d.kind = 3; d.A = hb; d.lda = DM; d.Bt = (const bfr*)(ws + OFF_WUP) + (size_t)layer * 4096 * 1024; d.ldb = 1024; d.M = T; d.N = 4096; d.K = 1024; d.rpart = rowss + (size_t)T * 16;
          d.e3 = EpiUp{ws};
        } break;
        case 7: {
          d.kind = 2; d.A = (const bfr*)(ws + OFF_S); d.lda = 4096; d.Bt = (const bfr*)(ws + OFF_WDN) + (size_t)layer * 1024 * 4096; d.ldb = 4096; d.M = T; d.N = 1024; d.K = 4096;
          d.e2 = EpiRes{p.out, p.out, hb, rowss};
        } break;
        case 8: {
          d.kind = 1; d.A = hb; d.lda = DM; d.Bt = (const bfr*)(ws + OFF_ODIN) + (size_t)li * 1280 * 1024; d.ldb = 1024; d.M = T; d.N = 1280; d.K = 1024; d.rpart = rowss;
          d.e1 = EpiOddIn{ws};
        } break;
        case 9: {
          for (int it = blockIdx.x; it < 4096; it += gridDim.x) { if (PHMASK & 64) s5_item<false>(p, li, it * 4 + wave, (float*)smem + wave * 2176); }
          if (xm.ok) {
            const int bg = xm.xcd >> 1, sub = xm.xcd & 1;
            for (int k = xm.loc; k < 512; k += xm.nloc) { if (PHMASK & 128) swa_item(p, li, bg * 4096 + (2 * k + sub) * 4 + wave); }
          } else {
            for (int it = blockIdx.x; it < 4096; it += gridDim.x) { if (PHMASK & 128) swa_item(p, li, it * 4 + wave); }
          }
        } break;
        case 10: { if (PHMASK & 256) for (int it = blockIdx.x; it < 4096; it += gridDim.x) s5_item<true>(p, li, it * 4 + wave, (float*)smem + wave * 2176); } break;
        default: {
          d.kind = 4; d.A = (const bfr*)(ws + OFF_S + 64 * MBy); d.lda = 512; d.Bt = (const bfr*)(ws + OFF_GLU) + (size_t)li * 512 * 512; d.ldb = 512; d.M = T; d.N = 512; d.K = 512;
          d.e4 = EpiGlu{ws, p.in[31] + li * 512};
        } break;
      }
      if ((PHMASK & 512) && d.kind >= 0) gemm_phase_(d, smem, xm);
      xcd_barrier(xb);
      }
    }
  }
  {
    const float* rs = rowss;
    const float* gf = p.in[3];
    const int lane = tid & 63;
    f32x4 gg[4];
#pragma unroll
    for (int i = 0; i < 4; ++i) gg[i] = *(const f32x4*)(gf + (i * 64 + lane) * 4);
#pragma unroll 1
    for (int row = (blockIdx.x * 4 + wave) * 2; row < T; row += gridDim.x * 8) {
      f32x4 v[2][4], pr[2][4];
#pragma unroll
      for (int rr = 0; rr < 2; ++rr) {
#pragma unroll
        for (int q = 0; q < 4; ++q) pr[rr][q] = *(const f32x4*)(rs + (size_t)(row + rr) * 16 + q * 4);
#pragma unroll
        for (int i = 0; i < 4; ++i) v[rr][i] = *(const f32x4*)(p.out + (size_t)(row + rr) * DM + (i * 64 + lane) * 4);
      }
      asm volatile("" ::: "memory"); __builtin_amdgcn_sched_barrier(0);
#pragma unroll
      for (int rr = 0; rr < 2; ++rr) {
        float sm = 0.f;
#pragma unroll
        for (int q = 0; q < 4; ++q) { sm += pr[rr][q][0]; sm += pr[rr][q][1]; sm += pr[rr][q][2]; sm += pr[rr][q][3]; }
        const float r = rsqrtf(sm * (1.f / DM) + EPS);
#pragma unroll
        for (int i = 0; i < 4; ++i) *(f32x4*)(p.out + (size_t)(row + rr) * DM + (i * 64 + lane) * 4) = v[rr][i] * gg[i] * r;
      }
    }
  }
}

extern "C" void kernel_launch(void* const* d_in, const int* in_sizes, int n_in, void* d_out, int out_size, void* d_ws, size_t ws_size, hipStream_t stream) {
  static int grid_blocks = 0;
  if (!grid_blocks) {
    int dev = 0, cus = 0, per_cu = 0;
    hipGetDevice(&dev);
    hipDeviceGetAttribute(&cus, hipDeviceAttributeMultiprocessorCount, dev);
    hipOccupancyMaxActiveBlocksPerMultiprocessor(&per_cu, fwd_mega, 256, 0);
    if (per_cu > 2) per_cu = 2;
    grid_blocks = cus * per_cu;
    if (ws_size < WS_NEED) { fprintf(stderr, "workspace too small: %zu < %zu\n", ws_size, (size_t)WS_NEED); grid_blocks = -1; }
  }
  if (grid_blocks <= 0) return;
  Params p{};
  for (int i = 0; i < 32 && i < n_in; ++i) p.in[i] = (const float*)d_in[i];
  p.out = (float*)d_out;
  p.ws = (unsigned char*)d_ws;
  unsigned char* ws = (unsigned char*)d_ws;
  int nj = 0, t0 = 0;
  auto add = [&](const float* src, size_t dstoff, const float* scale, int K, int N) {
    TJob& j = p.jobs[nj++];
    j.src = src; j.dst = (bfr*)(ws + dstoff); j.scale = scale; j.K = K; j.N = N; j.tile0 = t0; j.pad = 0;
    t0 += (K / 64) * (N / 32);
  };
  const float* const* in = (const float* const*)d_in;
  for (int l = 0; l < 4; ++l) {
    add(in[4] + (size_t)l * 1024 * 4096, OFF_WUP + (size_t)l * 4096 * 1024 * 2, in[2] + l * 1024, 1024, 4096);
    add(in[5] + (size_t)l * 4096 * 1024, OFF_WDN + (size_t)l * 1024 * 4096 * 2, nullptr, 4096, 1024);
  }
  for (int i = 0; i < 2; ++i) {
    add(in[6] + (size_t)i * 1024 * EVIN_N, OFF_EVIN + (size_t)i * EVIN_NP * 1024 * 2, in[1] + (2 * i) * 1024, 1024, EVIN_N);
    add(in[7] + (size_t)i * 1024 * 1024, OFF_EVOUT + (size_t)i * 1024 * 1024 * 2, nullptr, 1024, 1024);
    add(in[19] + (size_t)i * 1024 * 1280, OFF_ODIN + (size_t)i * 1280 * 1024 * 2, in[1] + (2 * i + 1) * 1024, 1024, 1280);
    add(in[20] + (size_t)i * 1024 * 1024, OFF_ODOUT + (size_t)i * 1024 * 1024 * 2, nullptr, 1024, 1024);
    add(in[30] + (size_t)i * 512 * 512, OFF_GLU + (size_t)i * 512 * 512 * 2, nullptr, 512, 512);
    for (int kv = 0; kv < 2; ++kv) {
      add(in[15] + (size_t)(i * 2 + kv) * 2048 * 256, OFF_W1 + (size_t)(i * 2 + kv) * 256 * 2048 * 2, nullptr, 2048, 256);
      add(in[17] + (size_t)(i * 2 + kv) * 256 * 64, OFF_W2 + (size_t)(i * 2 + kv) * 128 * 256 * 2, nullptr, 256, 64);
    }
  }
  p.njobs = nj; p.ntile_total = t0;
  hipMemsetAsync((unsigned char*)d_ws + OFF_BAR, 0, 16384, stream);
  void* args[] = {&p};
  hipError_t e = hipLaunchCooperativeKernel((void*)fwd_mega, dim3(grid_blocks), dim3(256), args, 0, stream);
  if (e != hipSuccess) fprintf(stderr, "cooperative launch failed: %s (grid %d)\n", hipGetErrorString(e), grid_blocks);
}
```

```cpp
#include <hip/hip_runtime.h>
#include <hip/hip_cooperative_groups.h>
#include <cstdio>
namespace cg = cooperative_groups;

typedef unsigned short bfr;
typedef short bf16x8 __attribute__((ext_vector_type(8)));
typedef short bf16x4 __attribute__((ext_vector_type(4)));
typedef float f32x2 __attribute__((ext_vector_type(2)));
typedef float f32x4 __attribute__((ext_vector_type(4)));
typedef float f32x16 __attribute__((ext_vector_type(16)));
typedef unsigned u32x4 __attribute__((ext_vector_type(4)));
typedef unsigned u32x2 __attribute__((ext_vector_type(2)));
typedef __bf16 bfv2 __attribute__((ext_vector_type(2)));
#define DI __device__ __forceinline__
#define MFMA32(a, b, c) __builtin_amdgcn_mfma_f32_32x32x16_bf16((a), (b), (c), 0, 0, 0)
#define MFMA16(a, b, c) __builtin_amdgcn_mfma_f32_16x16x32_bf16((a), (b), (c), 0, 0, 0)

#ifndef GEMMSEL
#define GEMMSEL 0xffff
#endif
#ifndef NSAREP
#define NSAREP 0
#endif
#ifndef REPMASK
#define REPMASK 0
#endif
#ifndef PHMASK
#define PHMASK 1023
#endif
constexpr int T = 32768, L = 16384, DM = 1024;
constexpr float EPS = 1e-6f;
constexpr float NEGF = -1e30f;
constexpr float QSC = 0.125f * 1.4426950408889634f;
constexpr float LOG2E = 1.4426950408889634f;
constexpr size_t MBy = 1u << 20;
constexpr size_t OFF_WUP = 0, OFF_WDN = 32 * MBy, OFF_EVIN = 64 * MBy, OFF_EVOUT = 76 * MBy, OFF_ODIN = 80 * MBy, OFF_ODOUT = 86 * MBy,
                 OFF_GLU = 90 * MBy, OFF_W1 = 91 * MBy, OFF_W2 = 95 * MBy, OFF_ROWSS = 120 * MBy, OFF_S5PRE = 98 * MBy, OFF_B1EFF = 99 * MBy,
                 OFF_DTRAW = 100 * MBy, OFF_DTT = 101 * MBy, OFF_ACUM = 102 * MBy, OFF_CDEC = 103 * MBy, OFF_GATES = 104 * MBy,
                 OFF_NSAHID = 107 * MBy, OFF_KC = 111 * MBy, OFF_VCT = 111 * MBy + 512 * 1024, OFF_S5S = 112 * MBy, OFF_HB = 124 * MBy,
                 OFF_MIX = 188 * MBy, OFF_S = 252 * MBy, OFF_BAR = 508 * MBy, WS_NEED = 508 * MBy + 65536;
constexpr int EVIN_N = 2848, EVIN_NP = 2944;

struct TJob { const float* src; bfr* dst; const float* scale; int K, N, tile0, pad; };
struct Params {
  const float* in[32];
  float* out;
  unsigned char* ws;
  TJob jobs[26];
  int njobs, ntile_total;
};

DI unsigned pk2(float a, float b) { f32x2 v = {a, b}; return __builtin_bit_cast(unsigned, __builtin_convertvector(v, bfv2)); }
DI bfr f2bf(float a) { return (bfr)(pk2(a, 0.f) & 0xffffu); }
DI float bf2f(bfr x) { return __uint_as_float(((unsigned)x) << 16); }
DI float bflo(unsigned u) { return __uint_as_float(u << 16); }
DI float bfhi(unsigned u) { return __uint_as_float(u & 0xffff0000u); }
DI bf16x8 pack8(float a, float b, float c, float d, float e, float f, float g, float h) {
  u32x4 r = {pk2(a, b), pk2(c, d), pk2(e, f), pk2(g, h)};
  return __builtin_bit_cast(bf16x8, r);
}
DI bf16x8 ld8(const bfr* p) { return *(const bf16x8*)p; }
DI int crow(int i, int half) { return (i & 3) + 8 * (i >> 2) + 4 * half; }
DI float sigmoidf_(float x) { return 1.f / (1.f + __expf(-x)); }
DI float siluf_(float x) { return x / (1.f + __expf(-x)); }
DI float gelu_tanh(float x) {
  float z = 0.7978845608028654f * (x + 0.044715f * x * x * x);
  float t = 1.f - 2.f / (__expf(2.f * z) + 1.f);
  return 0.5f * x * (1.f + t);
}
DI int otid() { int t = threadIdx.x; asm volatile("" : "+v"(t)); return t; }
DI float ex2(float x) { return __builtin_amdgcn_exp2f(x); }
typedef unsigned u2v __attribute__((ext_vector_type(2)));
DI float swsum32(float x, float y) { const u2v r = __builtin_amdgcn_permlane32_swap(__float_as_uint(x), __float_as_uint(y), false, false); return __uint_as_float(r[0]) + __uint_as_float(r[1]); }
DI float swsum16(float x, float y) { const u2v r = __builtin_amdgcn_permlane16_swap(__float_as_uint(x), __float_as_uint(y), false, false); return __uint_as_float(r[0]) + __uint_as_float(r[1]); }
template <int CTRL> DI float dppf(float v) { return __int_as_float(__builtin_amdgcn_mov_dpp(__float_as_int(v), CTRL, 0xf, 0xf, true)); }
DI float xor1(float v) { return dppf<0xB1>(v); }
DI float xor2(float v) { return dppf<0x4E>(v); }
DI float rmir(float v) { return dppf<0x140>(v); }
DI float rhmir(float v) { return dppf<0x141>(v); }
DI float swmax32(float x) { const u2v r = __builtin_amdgcn_permlane32_swap(__float_as_uint(x), __float_as_uint(x), false, false); return fmaxf(__uint_as_float(r[0]), __uint_as_float(r[1])); }
DI float swmax16(float x) { const u2v r = __builtin_amdgcn_permlane16_swap(__float_as_uint(x), __float_as_uint(x), false, false); return fmaxf(__uint_as_float(r[0]), __uint_as_float(r[1])); }
DI float swadd32(float x) { const u2v r = __builtin_amdgcn_permlane32_swap(__float_as_uint(x), __float_as_uint(x), false, false); return __uint_as_float(r[0]) + __uint_as_float(r[1]); }
DI float swadd16(float x) { const u2v r = __builtin_amdgcn_permlane16_swap(__float_as_uint(x), __float_as_uint(x), false, false); return __uint_as_float(r[0]) + __uint_as_float(r[1]); }
DI float shx(float v, int m) { return __shfl_xor(v, m, 64); }

#define XB_TMO      128
#define XB_XCNT(j)  (256  + 64 * (j))
#define XB_XSUB(j)  (1280 + 64 * (j))
#define XB_XGEN(j)  (2304 + 64 * (j))
#define XB_TOP      3328
#define XB_TOPGEN   3392
#define XCD_BAR_WORDS 3456
#define XB_SPIN_CAP (1u << 20)
#define LAS __attribute__((address_space(3)))
DI unsigned xb_ld(unsigned* p) { return __hip_atomic_load(p, __ATOMIC_RELAXED, __HIP_MEMORY_SCOPE_AGENT); }
DI unsigned xb_add(unsigned* p, unsigned v) { return __hip_atomic_fetch_add(p, v, __ATOMIC_RELAXED, __HIP_MEMORY_SCOPE_AGENT); }
DI unsigned xb_xcc_id() { return (unsigned)__builtin_amdgcn_s_getreg((3 << 11) | 20) & 0xFu; }
#define XB_SPIN(cond, bar) do { unsigned _sp = 0; while (cond) { __builtin_amdgcn_s_sleep(1); \
    if ((++_sp & 255u) == 0u) { if (xb_ld(&(bar)[XB_TMO])) break; if (_sp > XB_SPIN_CAP) { atomicAdd(&(bar)[XB_TMO], 1u); break; } } } } while (0)
struct XcdBarrier { unsigned* bar; unsigned x; volatile LAS unsigned* st; };
DI void xcd_barrier_complete(unsigned* bar, unsigned x, unsigned& nloc, unsigned& nx) {
  const unsigned G = gridDim.x * gridDim.y * gridDim.z;
  unsigned sum, cnt, mine, sp = 0u;
  for (;;) {
    sum = 0u; cnt = 0u; mine = 0u;
#pragma unroll
    for (unsigned j = 0; j < 16; ++j) { const unsigned c = xb_ld(&bar[XB_XCNT(j)]); sum += c; cnt += (c > 0u) ? 1u : 0u; mine = (j == x) ? c : mine; }
    if (sum == G) break;
    __builtin_amdgcn_s_sleep(1);
    if ((++sp & 255u) == 0u) { if (xb_ld(&bar[XB_TMO])) break; if (sp > XB_SPIN_CAP) { atomicAdd(&bar[XB_TMO], 1u); break; } }
  }
  nloc = mine > 0u ? mine : 1u; nx = cnt > 0u ? cnt : 1u;
}
DI void xcd_barrier(const XcdBarrier& b) {
  asm volatile("s_waitcnt vmcnt(0)" ::: "memory");
  __syncthreads();
  if (threadIdx.x == 0) {
    unsigned* bar = b.bar;
    __builtin_amdgcn_s_waitcnt(0);
    unsigned nloc = b.st[0], nx = b.st[1];
    if (nloc == 0u) { xcd_barrier_complete(bar, b.x, nloc, nx); b.st[0] = nloc; b.st[1] = nx; }
    const unsigned old = xb_add(&bar[XB_XSUB(b.x)], 1u);
    const unsigned gen = old / nloc;
    if (old + 1u == (gen + 1u) * nloc) {
      __builtin_amdgcn_fence(__ATOMIC_RELEASE, "agent");
      asm volatile("s_waitcnt vmcnt(0)" ::: "memory");
      const unsigned og = xb_add(&bar[XB_TOP], 1u);
      const unsigned tg = og / nx;
      if (og + 1u == (tg + 1u) * nx) xb_add(&bar[XB_TOPGEN], 1u);
      else XB_SPIN(xb_ld(&bar[XB_TOPGEN]) == tg, bar);
      __builtin_amdgcn_fence(__ATOMIC_ACQUIRE, "agent");
      xb_add(&bar[XB_XGEN(b.x)], 1u);
      asm volatile("s_waitcnt vmcnt(0)" ::: "memory");
    } else {
      XB_SPIN(xb_ld(&bar[XB_XGEN(b.x)]) == gen, bar);
      __builtin_amdgcn_fence(__ATOMIC_ACQUIRE, "agent");
      asm volatile("s_waitcnt vmcnt(0)" ::: "memory");
    }
  }
  __syncthreads();
}
struct XMap { int ok, xcd, loc, nloc; };

DI int vpos(int k64) { const int k = k64 & 31; return (k64 & 32) + ((k & 15) >> 2) * 8 + (k >> 4) * 4 + (k & 3); }
DI size_t kfoff(int key, int d) { return ((size_t)((key >> 4) * 2 + (d >> 5)) * 64 + ((d & 31) >> 3) * 16 + (key & 15)) * 8 + (d & 7); }
DI size_t vfoff(int key, int d) { return ((size_t)((key >> 5) * 4 + (d >> 4)) * 64 + ((key & 15) >> 2) * 16 + (d & 15)) * 8 + ((key >> 4) & 1) * 4 + (key & 3); }
DI u32x2 pk4(const f32x4& v) { u32x2 r = {pk2(v[0], v[1]), pk2(v[2], v[3])}; return r; }
struct EpiEvenIn {
  unsigned char* ws;
  DI void operator()(int, int t, int col, f32x4 v, float rs) const {
    if (col >= EVIN_N) return;
    bfr* zb = (bfr*)(ws + OFF_S + 64 * MBy); bfr* xraw = (bfr*)(ws + OFF_S); float* dtraw = (float*)(ws + OFF_DTRAW); bfr* qn = (bfr*)(ws + OFF_S + 96 * MBy); bfr* parts = (bfr*)(ws + OFF_S + 128 * MBy); float* gates = (float*)(ws + OFF_GATES);
    v *= rs;
    if (col < 512) *(u32x2*)(zb + (size_t)t * 512 + col) = pk4(v);
    else if (col < 1536) *(u32x2*)(xraw + (size_t)t * 1024 + col - 512) = pk4(v);
    else if (col < 1544) *(f32x4*)(dtraw + (size_t)t * 8 + col - 1536) = v;
    else if (col < 2056) *(u32x2*)(qn + (size_t)t * 512 + col - 1544) = pk4(v * QSC);
    else if (col < 2824) {
      const int w = col - 2056, part = w >> 7, g = (w >> 6) & 1, d = w & 63, b = t >> 14, tl = t & (L - 1);
      bfr* pb = parts + (size_t)part * (4u * MBy);
      if (part == 3 || part == 5) {
        bfr* q = pb + (size_t)(b * 2 + g) * L * 64 + vfoff(tl, d);
        q[0] = f2bf(v[0]); q[8] = f2bf(v[1]); q[16] = f2bf(v[2]); q[24] = f2bf(v[3]);
      } else if (part < 2) *(u32x2*)(pb + ((size_t)(b * 2 + g) * L + tl) * 64 + d) = pk4(v);
      else *(u32x2*)(pb + (size_t)(b * 2 + g) * L * 64 + kfoff(tl, d)) = pk4(v);
    } else {
      f32x4 o = {sigmoidf_(v[0]), sigmoidf_(v[1]), sigmoidf_(v[2]), sigmoidf_(v[3])};
      *(f32x4*)(gates + (size_t)t * 24 + col - 2824) = o;
    }
  }
};
struct EpiOddIn {
  unsigned char* ws;
  DI void operator()(int, int t, int col, f32x4 v, float rs) const {
    bfr* qn = (bfr*)(ws + OFF_S + 96 * MBy); bfr* ksw = (bfr*)(ws + OFF_S + 128 * MBy); bfr* vswT = (bfr*)(ws + OFF_S + 136 * MBy); float* us5 = (float*)(ws + OFF_S);
    v *= rs;
    const int b = t >> 14, tl = t & (L - 1);
    if (col < 512) *(u32x2*)(qn + (size_t)t * 512 + col) = pk4(v * QSC);
    else if (col < 640) { const int g = (col - 512) >> 6, d = col & 63; *(u32x2*)(ksw + (size_t)(b * 2 + g) * L * 64 + kfoff(tl, d)) = pk4(v); }
    else if (col < 768) {
      const int g = (col - 640) >> 6, d = col & 63;
      bfr* q = vswT + (size_t)(b * 2 + g) * L * 64 + vfoff(tl, d);
      q[0] = f2bf(v[0]); q[8] = f2bf(v[1]); q[16] = f2bf(v[2]); q[24] = f2bf(v[3]);
    } else *(f32x4*)(us5 + (size_t)t * 512 + col - 768) = v;
  }
};
struct EpiRes {
  const float* hin; float* hout; bfr* hb; float* rowss_next;
  DI void operator()(int, int t, int col, f32x4 a, float) const {
    const f32x4 v = *(const f32x4*)(hin + (size_t)t * DM + col) + a;
    *(f32x4*)(hout + (size_t)t * DM + col) = v;
    *(u32x2*)(hb + (size_t)t * DM + col) = pk4(v);
    float s = v[0] * v[0] + v[1] * v[1] + v[2] * v[2] + v[3] * v[3];
    s += shx(s, 1); s += shx(s, 2); s += shx(s, 4);
    if ((threadIdx.x & 7) == 0) {
      float* pp = rowss_next + (size_t)t * 16 + (col >> 6);
      if (col & 32) s += *pp;
      *pp = s;
    }
  }
};
struct EpiUp {
  unsigned char* ws;
  DI void operator()(int, int t, int col, f32x4 v, float rs) const {
    bfr* hid = (bfr*)(ws + OFF_S);
    v *= rs;
#pragma unroll
    for (int i = 0; i < 4; ++i) v[i] = v[i] > 0.f ? v[i] * v[i] : 0.f;
    *(u32x2*)(hid + (size_t)t * 4096 + col) = pk4(v);
  }
};
struct EpiGlu {
  unsigned char* ws; const float* bias;
  DI void operator()(int, int t, int col, f32x4 a, float) const {
    const bfr* yg = (const bfr*)(ws + OFF_S + 64 * MBy); bfr* mix = (bfr*)(ws + OFF_MIX);
    const u32x2 yv = *(const u32x2*)(yg + (size_t)t * 512 + col);
    const f32x4 bb = *(const f32x4*)(bias + col);
    f32x4 o = {bflo(yv[0]) * sigmoidf_(a[0] + bb[0]), bfhi(yv[0]) * sigmoidf_(a[1] + bb[1]), bflo(yv[1]) * sigmoidf_(a[2] + bb[2]), bfhi(yv[1]) * sigmoidf_(a[3] + bb[3])};
    *(u32x2*)(mix + (size_t)t * DM + 512 + col) = pk4(o);
  }
};
struct EpiW1 {
  unsigned char* ws; int li;
  DI void operator()(int z, int r, int col, f32x4 a, float) const {
    const float* b1eff = (const float*)(ws + OFF_B1EFF) + li * 512; bfr* hid = (bfr*)(ws + OFF_NSAHID);
    const f32x4 bb = *(const f32x4*)(b1eff + z * 256 + col);
    f32x4 o = {gelu_tanh(a[0] + bb[0]), gelu_tanh(a[1] + bb[1]), gelu_tanh(a[2] + bb[2]), gelu_tanh(a[3] + bb[3])};
    *(u32x2*)(hid + ((size_t)z * 4096 + r) * 256 + col) = pk4(o);
  }
};
struct EpiW2 {
  unsigned char* ws; const float* b2;
  DI void operator()(int z, int r, int col, f32x4 a, float) const {
    if (col >= 64) return;
    bfr* kc = (bfr*)(ws + OFF_KC); bfr* vcT = (bfr*)(ws + OFF_VCT);
    const int bg = r >> 10, n = r & 1023;
    const f32x4 bb = *(const f32x4*)(b2 + z * 64 + col);
    f32x4 v = a + bb;
    if (n == 1023) v = (f32x4){0.f, 0.f, 0.f, 0.f};
    if (z == 0) *(u32x2*)(kc + (size_t)bg * 1024 * 64 + kfoff(n, col)) = pk4(v);
    else {
      bfr* q = vcT + (size_t)bg * 1024 * 64 + vfoff(n, col);
      q[0] = f2bf(v[0]); q[8] = f2bf(v[1]); q[16] = f2bf(v[2]); q[24] = f2bf(v[3]);
    }
  }
};

struct GemmDesc {
  const bfr* A; const bfr* Bt; const float* rpart; size_t sA, sB; int lda, ldb, M, N, K, nbatch, kind;
  EpiEvenIn e0; EpiOddIn e1; EpiRes e2; EpiUp e3; EpiGlu e4; EpiW1 e5; EpiW2 e6;
};
DI void epi_dispatch(const GemmDesc& d, int z, int row, int col, const f32x4& a, float rs) {
  switch (d.kind) {
    case 0: d.e0(z, row, col, a, rs); break;
    case 1: d.e1(z, row, col, a, rs); break;
    case 2: d.e2(z, row, col, a, rs); break;
    case 3: d.e3(z, row, col, a, rs); break;
    case 4: d.e4(z, row, col, a, rs); break;
    case 5: d.e5(z, row, col, a, rs); break;
    default: d.e6(z, row, col, a, rs); break;
  }
}
constexpr int GLD = 72;
DI void gemm_phase_(const GemmDesc& d, unsigned char* smem, const XMap& xm) {
  const bfr* __restrict__ A = d.A; const bfr* __restrict__ Bt = d.Bt; const float* rpart = d.rpart;
  const int lda = d.lda, ldb = d.ldb, M = d.M, N = d.N, K = d.K, nbatch = d.nbatch; const size_t sA = d.sA, sB = d.sB;
  bfr* sAq = (bfr*)smem;
  bfr* sBq = sAq + 256 * GLD;
  const int tid = otid(), lane = tid & 63, wave = tid >> 6, wm = wave >> 1, wn = wave & 1, half = lane >> 5, l32 = lane & 31;
  const int MT = M / 256, NT = N / 128, KT = K / 64;
  const int per = MT * NT, ntile = per * nbatch;
  const bool xmap = xm.ok && (((MT * nbatch) & 63) == 0);
  const int nloc = xm.nloc, xcd = xm.xcd, loc = xm.loc, MTx = (MT * nbatch) >> 3;
  const int tstart = xmap ? loc : blockIdx.x, tstep = xmap ? nloc : gridDim.x, tend = xmap ? MTx * NT : ntile;
  const int lrow = tid >> 3, lcc = (tid & 7) * 8;
  u32x4 ra[8], rb[4];
  const bfr* Ap = A; const bfr* Bp = Bt;
  int z = 0, mt = 0, nt = 0;
#define DECODE(TILE, Z, MTv, NTv) { if (xmap) { const int grp = (TILE) / (8 * NT), rem = (TILE) - grp * 8 * NT; NTv = rem >> 3; const int mg = xcd * MTx + grp * 8 + (rem & 7); Z = mg / MT; MTv = mg - Z * MT; } \
    else { Z = (TILE) / per; const int id = (TILE) % per; const int grp = id / (16 * NT), rem = id % (16 * NT); const int gm = (MT - grp * 16) < 16 ? (MT - grp * 16) : 16; MTv = grp * 16 + rem % gm; NTv = rem / gm; } }
#define GLOADS(K0) { _Pragma("unroll") for (int i = 0; i < 8; ++i) ra[i] = *(const u32x4*)(Ap + (size_t)(32 * i) * lda + (K0)); \
                     _Pragma("unroll") for (int i = 0; i < 4; ++i) rb[i] = *(const u32x4*)(Bp + (size_t)(32 * i) * ldb + (K0)); }
  for (int tile = tstart; tile < tend; tile += tstep) {
    DECODE(tile, z, mt, nt);
    Ap = A + z * sA + (size_t)(mt * 256 + lrow) * lda + lcc;
    Bp = Bt + z * sB + (size_t)(nt * 128 + lrow) * ldb + lcc;
    GLOADS(0);
    f32x16 acc[4][2];
#pragma unroll
    for (int i = 0; i < 4; ++i)
#pragma unroll
      for (int j = 0; j < 2; ++j)
#pragma unroll
        for (int r = 0; r < 16; ++r) acc[i][j][r] = 0.f;
    for (int kt = 0; kt < KT; ++kt) {
      __syncthreads();
#pragma unroll
      for (int i = 0; i < 8; ++i) *(u32x4*)(sAq + (lrow + 32 * i) * GLD + lcc) = ra[i];
#pragma unroll
      for (int i = 0; i < 4; ++i) *(u32x4*)(sBq + (lrow + 32 * i) * GLD + lcc) = rb[i];
      __syncthreads();
      if (kt + 1 < KT) GLOADS((kt + 1) * 64);
      __builtin_amdgcn_s_setprio(3);
#pragma unroll
      for (int ks = 0; ks < 4; ++ks) {
        bf16x8 bq[2];
#pragma unroll
        for (int j = 0; j < 2; ++j) bq[j] = *(const bf16x8*)(sBq + (wn * 64 + j * 32 + l32) * GLD + ks * 16 + half * 8);
#pragma unroll
        for (int ih = 0; ih < 2; ++ih) {
          bf16x8 af[2];
#pragma unroll
          for (int i = 0; i < 2; ++i) af[i] = *(const bf16x8*)(sAq + (wm * 128 + (ih * 2 + i) * 32 + l32) * GLD + ks * 16 + half * 8);
#pragma unroll
          for (int i = 0; i < 2; ++i)
#pragma unroll
            for (int j = 0; j < 2; ++j) acc[ih * 2 + i][j] = MFMA32(af[i], bq[j], acc[ih * 2 + i][j]);
        }
      }
      __builtin_amdgcn_s_setprio(0);
    }
    const int zc = z, mtc = mt, ntc = nt;
    __syncthreads();
    float* rsl = (float*)smem + 13824;
    if (rpart) {
      {
        const float* pp = rpart + (size_t)(mtc * 256 + tid) * 16;
        float sm = 0.f;
#pragma unroll
        for (int q = 0; q < 4; ++q) { const f32x4 v = *(const f32x4*)(pp + q * 4); sm += v[0]; sm += v[1]; sm += v[2]; sm += v[3]; }
        rsl[tid] = rsqrtf(sm * (1.f / DM) + EPS);
      }
      __syncthreads();
    }
    {
      float* eb = (float*)smem + wave * 2304;
      const int er = lane >> 3, ec = (lane & 7) * 4;
#pragma unroll
      for (int ip = 0; ip < 2; ++ip)
#pragma unroll
        for (int j = 0; j < 2; ++j) {
#pragma unroll
          for (int i = 0; i < 2; ++i)
#pragma unroll
            for (int e = 0; e < 16; ++e) eb[(i * 32 + crow(e, half)) * 36 + l32] = acc[ip * 2 + i][j][e];
          __builtin_amdgcn_wave_barrier();
          const int colg = ntc * 128 + wn * 64 + j * 32 + ec, rowl = wm * 128 + ip * 64 + er, rowg = mtc * 256 + rowl;
          if (d.kind == 2) {
#pragma unroll
            for (int kb = 0; kb < 8; kb += 4) {
              f32x4 hv[4];
#pragma unroll
              for (int k = 0; k < 4; ++k) hv[k] = *(const f32x4*)(d.e2.hin + (size_t)(rowg + 8 * (kb + k)) * DM + colg);
              asm volatile("" ::: "memory"); __builtin_amdgcn_sched_barrier(0);
#pragma unroll
              for (int k = 0; k < 4; ++k) {
                const int t = rowg + 8 * (kb + k);
                const f32x4 v = *(const f32x4*)(eb + ((kb + k) * 8 + er) * 36 + ec) + hv[k];
                *(f32x4*)(d.e2.hout + (size_t)t * DM + colg) = v;
                *(u32x2*)(d.e2.hb + (size_t)t * DM + colg) = pk4(v);
                float sq = v[0] * v[0] + v[1] * v[1] + v[2] * v[2] + v[3] * v[3];
                sq += xor1(sq); sq += xor2(sq); sq += rhmir(sq);
                if ((lane & 7) == 0) {
                  float* pp = d.e2.rowss_next + (size_t)t * 16 + (colg >> 6);
                  if (colg & 32) sq += *pp;
                  *pp = sq;
                }
              }
              asm volatile("" ::: "memory");
            }
          } else if (d.kind == 4) {
            const bfr* ygp = (const bfr*)(d.e4.ws + OFF_S + 64 * MBy);
            bfr* mixp = (bfr*)(d.e4.ws + OFF_MIX);
            const f32x4 bb = *(const f32x4*)(d.e4.bias + colg);
            u32x2 yv[8];
#pragma unroll
            for (int k = 0; k < 8; ++k) yv[k] = *(const u32x2*)(ygp + (size_t)(rowg + 8 * k) * 512 + colg);
            asm volatile("" ::: "memory"); __builtin_amdgcn_sched_barrier(0);
#pragma unroll
            for (int k = 0; k < 8; ++k) {
              const f32x4 a = *(const f32x4*)(eb + (k * 8 + er) * 36 + ec);
              f32x4 o = {bflo(yv[k][0]) * sigmoidf_(a[0] + bb[0]), bfhi(yv[k][0]) * sigmoidf_(a[1] + bb[1]), bflo(yv[k][1]) * sigmoidf_(a[2] + bb[2]), bfhi(yv[k][1]) * sigmoidf_(a[3] + bb[3])};
              *(u32x2*)(mixp + (size_t)(rowg + 8 * k) * DM + 512 + colg) = pk4(o);
            }
          } else {
#pragma unroll 2
            for (int k = 0; k < 8; ++k) {
              const f32x4 v = *(const f32x4*)(eb + (k * 8 + er) * 36 + ec);
              epi_dispatch(d, zc, rowg + 8 * k, colg, v, rpart ? rsl[rowl + 8 * k] : 1.f);
            }
          }
          __builtin_amdgcn_wave_barrier();
        }
    }
  }
#undef GLOADS
#undef DECODE
}

DI void prep_phase(const Params& p, unsigned char* smem) {
  const int tid = otid(), lane = tid & 63, wave = tid >> 6;
  unsigned char* ws = p.ws;
  float (*tl)[33] = (float (*)[33])smem;
  for (int tix = blockIdx.x; tix < p.ntile_total; tix += gridDim.x) {
    int j = 0;
    while (j + 1 < p.njobs && p.jobs[j + 1].tile0 <= tix) ++j;
    const TJob& jb = p.jobs[j];
    const int loc = tix - jb.tile0, ntn = jb.N / 32, kt = loc / ntn, nt = loc % ntn;
    __syncthreads();
#pragma unroll
    for (int i = 0; i < 8; ++i) {
      const int r = (tid >> 5) + 8 * i, c = tid & 31;
      float v = jb.src[(size_t)(kt * 64 + r) * jb.N + nt * 32 + c];
      if (jb.scale) v *= jb.scale[kt * 64 + r];
      tl[r][c] = v;
    }
    __syncthreads();
    {
      const int n = tid >> 3, k0 = (tid & 7) * 8;
      const bf16x8 o = pack8(tl[k0][n], tl[k0 + 1][n], tl[k0 + 2][n], tl[k0 + 3][n], tl[k0 + 4][n], tl[k0 + 5][n], tl[k0 + 6][n], tl[k0 + 7][n]);
      *(bf16x8*)(jb.dst + (size_t)(nt * 32 + n) * jb.K + kt * 64 + k0) = o;
    }
  }
  const int gtid = blockIdx.x * 256 + tid, gsz = gridDim.x * 256;
  {
    bfr* evin = (bfr*)(ws + OFF_EVIN);
    for (int i = gtid; i < 2 * 96 * 1024; i += gsz) { const int inst = i / (96 * 1024), r = i % (96 * 1024); evin[(size_t)inst * EVIN_NP * 1024 + (size_t)EVIN_N * 1024 + r] = 0; }
    bfr* w2 = (bfr*)(ws + OFF_W2);
    for (int i = gtid; i < 4 * 64 * 256; i += gsz) { const int inst = i / (64 * 256), r = i % (64 * 256); w2[(size_t)inst * 128 * 256 + 64 * 256 + r] = 0; }
  }
  {
    const float* x = p.in[0];
    bfr* hb = (bfr*)(ws + OFF_HB);
    float* rs = (float*)(ws + OFF_ROWSS);
    for (int row = blockIdx.x * 4 + wave; row < T; row += gridDim.x * 4) {
      float s = 0.f;
#pragma unroll
      for (int i = 0; i < 4; ++i) {
        const int c = (i * 64 + lane) * 4;
        const f32x4 v = *(const f32x4*)(x + (size_t)row * DM + c);
        s += v[0] * v[0] + v[1] * v[1] + v[2] * v[2] + v[3] * v[3];
        u32x2 o = {pk2(v[0], v[1]), pk2(v[2], v[3])};
        *(u32x2*)(hb + (size_t)row * DM + c) = o;
      }
      s += shx(s, 1); s += shx(s, 2); s += shx(s, 4); s += shx(s, 8); s += shx(s, 16); s += shx(s, 32);
      if (lane < 16) rs[(size_t)row * 16 + lane] = lane == 0 ? s : 0.f;
    }
  }
  for (int e = gtid; e < 2 * 32 * 64; e += gsz) {
    const int i = e >> 11, gp = e & 2047, g = gp >> 6;
    const float are = p.in[22][e], aim = p.in[23][e], step = expf(p.in[24][i * 32 + g]);
    const float mag = expf(are * step), ph = aim * step;
    const float lre = mag * cosf(ph), lim = mag * sinf(ph);
    float pre = lre, pim = lim;
    for (int k = 0; k < 6; ++k) { const float nr = pre * pre - pim * pim, ni = 2.f * pre * pim; pre = nr; pim = ni; }
    const float nre = lre - 1.f, nim = lim, den = are * are + aim * aim;
    const float fre = (nre * are + nim * aim) / den, fim = (nim * are - nre * aim) / den;
    float* pre_ = (float*)(ws + OFF_S5PRE) + (size_t)i * 131072;
    pre_[gp * 2] = lre; pre_[gp * 2 + 1] = lim;
    pre_[4096 + gp * 2] = pre; pre_[4096 + gp * 2 + 1] = pim;
    float* bb = pre_ + 8192 + (size_t)gp * 32;
    for (int h = 0; h < 16; ++h) {
      const float bre = p.in[25][(size_t)e * 16 + h], bim = p.in[26][(size_t)e * 16 + h];
      bb[h] = fre * bre - fim * bim; bb[16 + h] = fre * bim + fim * bre;
    }
  }
  for (int e = gtid; e < 16 * 1024; e += gsz) {
    const int sl = e >> 10, o = e & 1023, ikv = o >> 8, n = o & 255;
    const float* pe = p.in[14] + (size_t)ikv * 2048 + sl * 128;
    const float* w1 = p.in[15] + (size_t)ikv * 2048 * 256 + (size_t)sl * 128 * 256 + n;
    float acc = 0.f;
#pragma unroll 1
    for (int k0 = 0; k0 < 128; k0 += 8) {
      float wv[8], pv[8];
#pragma unroll
      for (int k = 0; k < 8; ++k) { wv[k] = w1[(size_t)(k0 + k) * 256]; pv[k] = pe[k0 + k]; }
#pragma unroll
      for (int k = 0; k < 8; ++k) acc += pv[k] * wv[k];
    }
    ((float*)(ws + OFF_B1EFF))[1024 + e] = acc;
  }
}

DI void ssd_conv_phase(const Params& p, int ei, unsigned char* smem) {
  unsigned char* ws = p.ws;
  const bfr* xraw = (const bfr*)(ws + OFF_S);
  bfr* bct = (bfr*)(ws + OFF_HB);
  bfr* xbT = (bfr*)(ws + OFF_S + 176 * MBy);
  const float* cw = p.in[8] + (size_t)ei * 4 * 1024;
  const float* cb = p.in[9] + (size_t)ei * 1024;
  const int tid = otid(), lane = tid & 63, wave = tid >> 6;
  bfr* tile = (bfr*)smem;
  const int nconv = 256 * 16;
  for (int item = blockIdx.x; item < nconv + 256; item += gridDim.x) {
    if (item < nconv) {
      const int bc = item >> 4, slab = item & 15, c = slab * 64 + lane, tq = wave;
      const int b = bc >> 7, chunk = bc & 127, t0l = chunk * 128 + tq * 32;
      const size_t tg0 = (size_t)b * L + t0l;
      const float w0 = cw[c], w1 = cw[1024 + c], w2 = cw[2048 + c], w3 = cw[3072 + c], bias = cb[c];
      float r0 = (t0l >= 3) ? bf2f(xraw[(tg0 - 3) * 1024 + c]) : 0.f;
      float r1 = (t0l >= 2) ? bf2f(xraw[(tg0 - 2) * 1024 + c]) : 0.f;
      float r2 = (t0l >= 1) ? bf2f(xraw[(tg0 - 1) * 1024 + c]) : 0.f;
      __syncthreads();
      for (int k = 0; k < 32; ++k) {
        const float r3 = bf2f(xraw[(tg0 + k) * 1024 + c]);
        const float y = siluf_(bias + w0 * r0 + w1 * r1 + w2 * r2 + w3 * r3);
        r0 = r1; r1 = r2; r2 = r3;
        const bfr yb = f2bf(y);
        if (slab >= 8) bct[(tg0 + k) * 512 + c - 512] = yb;
        if (slab < 12) tile[lane * 136 + tq * 32 + k] = yb;
      }
      __syncthreads();
      if (slab < 12) {
#pragma unroll
        for (int i = 0; i < 4; ++i) {
          const int cid = tid + 256 * i, row = cid >> 4, cc = cid & 15;
          *(u32x4*)(xbT + ((size_t)bc * 768 + slab * 64 + row) * 128 + cc * 8) = *(const u32x4*)(tile + row * 136 + cc * 8);
        }
      }
    } else {
      const int bc = item - nconv;
      const float* dtraw = (const float*)(ws + OFF_DTRAW);
      float* dtT = (float*)(ws + OFF_DTT);
      float* acum = (float*)(ws + OFF_ACUM);
      float* cdec = (float*)(ws + OFF_CDEC);
      for (int hh = 0; hh < 2; ++hh) {
        const int h = wave * 2 + hh;
        const float bias = p.in[10][ei * 8 + h], a = -expf(p.in[11][ei * 8 + h]);
        float d0 = dtraw[((size_t)bc * 128 + lane) * 8 + h] + bias, d1 = dtraw[((size_t)bc * 128 + 64 + lane) * 8 + h] + bias;
        d0 = d0 > 20.f ? d0 : log1pf(expf(d0)); d1 = d1 > 20.f ? d1 : log1pf(expf(d1));
        float s0 = d0 * a, s1 = d1 * a;
#pragma unroll
        for (int off = 1; off < 64; off <<= 1) {
          const float u0 = __shfl_up(s0, off, 64), u1 = __shfl_up(s1, off, 64);
          if (lane >= off) { s0 += u0; s1 += u1; }
        }
        const float tot0 = __shfl(s0, 63, 64);
        s1 += tot0;
        const size_t o = ((size_t)bc * 8 + h) * 128;
        dtT[o + lane] = d0; dtT[o + 64 + lane] = d1;
        acum[o + lane] = s0; acum[o + 64 + lane] = s1;
        if (lane == 63) cdec[bc * 8 + h] = expf(s1);
      }
    }
  }
}

DI void ssd_states_item(const Params& p, int witem, float* wl  ) {
  unsigned char* ws = p.ws;
  const bfr* xbT = (const bfr*)(ws + OFF_S + 176 * MBy);
  const float* dtT = (const float*)(ws + OFF_DTT);
  const float* acum = (const float*)(ws + OFF_ACUM);
  float* states = (float*)(ws + OFF_S);
  const int lane = otid() & 63, half = lane >> 5, l32 = lane & 31;
  const int bc = witem >> 3, head = witem & 7, g = head >> 2;
  const size_t o = ((size_t)bc * 8 + head) * 128;
  const float alast = acum[o + 127];
  wl[lane] = dtT[o + lane] * __expf(alast - acum[o + lane]);
  wl[64 + lane] = dtT[o + 64 + lane] * __expf(alast - acum[o + 64 + lane]);
  __builtin_amdgcn_wave_barrier();
  __builtin_amdgcn_s_waitcnt(0xc07f);
  const bfr* xrow = xbT + ((size_t)bc * 768 + head * 64) * 128;
  const bfr* brow = xbT + ((size_t)bc * 768 + 512 + g * 128) * 128;
  float* so = states + ((size_t)bc * 8 + head) * 8192;
#pragma unroll 1
  for (int nh = 0; nh < 2; ++nh) {
    f32x16 acc[2][2];
#pragma unroll
    for (int i = 0; i < 2; ++i)
#pragma unroll
      for (int j = 0; j < 2; ++j)
#pragma unroll
        for (int r = 0; r < 16; ++r) acc[i][j][r] = 0.f;
#pragma unroll 2
    for (int ks = 0; ks < 8; ++ks) {
      const int tb = ks * 16 + half * 8;
      const f32x4 s0 = *(const f32x4*)(wl + tb), s1 = *(const f32x4*)(wl + tb + 4);
      bf16x8 af[2], bq[2];
#pragma unroll
      for (int mt = 0; mt < 2; ++mt) {
        const u32x4 raw = *(const u32x4*)(xrow + (size_t)(mt * 32 + l32) * 128 + tb);
        af[mt] = pack8(bflo(raw[0]) * s0[0], bfhi(raw[0]) * s0[1], bflo(raw[1]) * s0[2], bfhi(raw[1]) * s0[3],
                       bflo(raw[2]) * s1[0], bfhi(raw[2]) * s1[1], bflo(raw[3]) * s1[2], bfhi(raw[3]) * s1[3]);
      }
#pragma unroll
      for (int nt = 0; nt < 2; ++nt) bq[nt] = ld8(brow + (size_t)((nh * 2 + nt) * 32 + l32) * 128 + tb);
#pragma unroll
      for (int mt = 0; mt < 2; ++mt)
#pragma unroll
        for (int nt = 0; nt < 2; ++nt) acc[mt][nt] = MFMA32(af[mt], bq[nt], acc[mt][nt]);
    }
#pragma unroll
    for (int mt = 0; mt < 2; ++mt)
#pragma unroll
      for (int nt = 0; nt < 2; ++nt)
#pragma unroll
        for (int i = 0; i < 16; ++i) so[(size_t)(mt * 32 + crow(i, half)) * 128 + (nh * 2 + nt) * 32 + l32] = acc[mt][nt][i];
  }
  __builtin_amdgcn_wave_barrier();
}

DI void ssd_carry_item(const Params& p, int bitem) {
  unsigned char* ws = p.ws;
  float* states = (float*)(ws + OFF_S);
  const float* cdec = (const float*)(ws + OFF_CDEC);
  const int e = bitem * 256 + otid();
  const int b = e >> 16, head = (e >> 13) & 7, pn = e & 8191;
  float run = 0.f;
#pragma unroll 1
  for (int c0 = 0; c0 < 128; c0 += 32) {
    float sv[32], dv[32];
#pragma unroll
    for (int k = 0; k < 32; ++k) {
      const int bc = b * 128 + c0 + k;
      sv[k] = states[((size_t)bc * 8 + head) * 8192 + pn];
      dv[k] = cdec[bc * 8 + head];
    }
    asm volatile("" ::: "memory"); __builtin_amdgcn_sched_barrier(0);
#pragma unroll
    for (int k = 0; k < 32; ++k) {
      const int bc = b * 128 + c0 + k;
      states[((size_t)bc * 8 + head) * 8192 + pn] = run;
      run = run * dv[k] + sv[k];
    }
  }
}

DI void ssd_out_phase(const Params& p, int ei, unsigned char* smem) {
  unsigned char* ws = p.ws;
  const bfr* xbT = (const bfr*)(ws + OFF_S + 176 * MBy);
  const bfr* bct = (const bfr*)(ws + OFF_HB);
  const bfr* zb = (const bfr*)(ws + OFF_S + 64 * MBy);
  const float* dtT = (const float*)(ws + OFF_DTT);
  const float* acum = (const float*)(ws + OFF_ACUM);
  const float* states = (const float*)(ws + OFF_S);
  bfr* mix = (bfr*)(ws + OFF_MIX);
  const int tid = otid(), lane = tid & 63, wave = tid >> 6, half = lane >> 5, l32 = lane & 31;
  float* wac = (float*)smem + wave * 256;
  float* ssq = (float*)smem + 1024;
  for (int item = blockIdx.x; item < 512; item += gridDim.x) {
    const int bc = item >> 1, g = item & 1, head = g * 4 + wave;
    const size_t tg0 = (size_t)bc * 128;
    const size_t o = ((size_t)bc * 8 + head) * 128;
    __syncthreads();
    wac[lane] = acum[o + lane]; wac[64 + lane] = acum[o + 64 + lane];
    wac[128 + lane] = dtT[o + lane]; wac[192 + lane] = dtT[o + 64 + lane];
    __syncthreads();
    const bfr* Cm = bct + tg0 * 512 + 256 + g * 128;
    const bfr* Bm = bct + tg0 * 512 + g * 128;
    const float* hin = states + ((size_t)bc * 8 + head) * 8192;
    const bfr* xrow = xbT + ((size_t)bc * 768 + head * 64) * 128;
    const float dsk = p.in[12][ei * 8 + head];
    const float* ng = p.in[13] + (size_t)ei * 512 + head * 64;
    const float g0 = ng[l32], g1 = ng[32 + l32];
#pragma unroll 1
    for (int tt = 0; tt < 4; ++tt) {
      f32x16 Y0, Y1;
#pragma unroll
      for (int r = 0; r < 16; ++r) { Y0[r] = 0.f; Y1[r] = 0.f; }
      bf16x8 cfr[8];
#pragma unroll
      for (int ks = 0; ks < 8; ++ks) cfr[ks] = ld8(Cm + (size_t)(tt * 32 + l32) * 512 + ks * 16 + half * 8);
#pragma unroll
      for (int kb = 0; kb < 8; kb += 4) {
        f32x4 ha[4][4];
#pragma unroll
        for (int k = 0; k < 4; ++k) {
          const float* hp0 = hin + (size_t)l32 * 128 + (kb + k) * 16 + half * 8;
          ha[k][0] = *(const f32x4*)hp0; ha[k][1] = *(const f32x4*)(hp0 + 4);
          ha[k][2] = *(const f32x4*)(hp0 + 32 * 128); ha[k][3] = *(const f32x4*)(hp0 + 32 * 128 + 4);
        }
        asm volatile("" ::: "memory"); __builtin_amdgcn_sched_barrier(0);
#pragma unroll
        for (int k = 0; k < 4; ++k) {
          Y0 = MFMA32(cfr[kb + k], pack8(ha[k][0][0], ha[k][0][1], ha[k][0][2], ha[k][0][3], ha[k][1][0], ha[k][1][1], ha[k][1][2], ha[k][1][3]), Y0);
          Y1 = MFMA32(cfr[kb + k], pack8(ha[k][2][0], ha[k][2][1], ha[k][2][2], ha[k][2][3], ha[k][3][0], ha[k][3][1], ha[k][3][2], ha[k][3][3]), Y1);
        }
      }
#pragma unroll
      for (int i = 0; i < 16; ++i) {
        const float e = __expf(wac[tt * 32 + crow(i, half)]);
        Y0[i] *= e; Y1[i] *= e;
      }
      const float at = wac[tt * 32 + l32];
      const int tl = tt * 32 + l32;
#pragma unroll 1
      for (int st = 0; st <= tt; ++st) {
        f32x16 X;
#pragma unroll
        for (int r = 0; r < 16; ++r) X[r] = 0.f;
        bf16x8 bfm[8];
        u32x2 xq[8];
#pragma unroll
        for (int ks = 0; ks < 8; ++ks) bfm[ks] = ld8(Bm + (size_t)(st * 32 + l32) * 512 + ks * 16 + half * 8);
#pragma unroll
        for (int k2 = 0; k2 < 2; ++k2) {
          const bfr* xp = xrow + (size_t)l32 * 128 + st * 32 + 16 * k2 + 4 * half;
          xq[k2 * 4] = *(const u32x2*)xp; xq[k2 * 4 + 1] = *(const u32x2*)(xp + 8);
          xq[k2 * 4 + 2] = *(const u32x2*)(xp + 32 * 128); xq[k2 * 4 + 3] = *(const u32x2*)(xp + 32 * 128 + 8);
        }
        asm volatile("" ::: "memory"); __builtin_amdgcn_sched_barrier(0);
#pragma unroll
        for (int ks = 0; ks < 8; ++ks) X = MFMA32(bfm[ks], cfr[ks], X);
#pragma unroll
        for (int i = 0; i < 16; ++i) {
          const int s_ = st * 32 + crow(i, half);
          const float f = (s_ <= tl) ? __expf(at - wac[s_]) * wac[128 + s_] : 0.f;
          X[i] *= f;
        }
#pragma unroll
        for (int k2 = 0; k2 < 2; ++k2) {
          const bf16x8 pa = pack8(X[8 * k2], X[8 * k2 + 1], X[8 * k2 + 2], X[8 * k2 + 3], X[8 * k2 + 4], X[8 * k2 + 5], X[8 * k2 + 6], X[8 * k2 + 7]);
          const u32x4 xv0 = {xq[k2 * 4][0], xq[k2 * 4][1], xq[k2 * 4 + 1][0], xq[k2 * 4 + 1][1]}, xv1 = {xq[k2 * 4 + 2][0], xq[k2 * 4 + 2][1], xq[k2 * 4 + 3][0], xq[k2 * 4 + 3][1]};
          Y0 = MFMA32(pa, __builtin_bit_cast(bf16x8, xv0), Y0);
          Y1 = MFMA32(pa, __builtin_bit_cast(bf16x8, xv1), Y1);
        }
      }
#pragma unroll
      for (int q = 0; q < 4; ++q) {
        const bfr* xq = xrow + (size_t)l32 * 128 + tt * 32 + 8 * q + 4 * half;
        const u32x2 xa = *(const u32x2*)xq, xb = *(const u32x2*)(xq + 32 * 128);
        const float xs0[4] = {bflo(xa[0]), bfhi(xa[0]), bflo(xa[1]), bfhi(xa[1])};
        const float xs1[4] = {bflo(xb[0]), bfhi(xb[0]), bflo(xb[1]), bfhi(xb[1])};
#pragma unroll
        for (int j = 0; j < 4; ++j) {
          const int i = q * 4 + j;
          const int t = tt * 32 + 8 * q + 4 * half + j;
          const bfr* zp = zb + (tg0 + t) * 512 + head * 64 + l32;
          Y0[i] = (Y0[i] + dsk * xs0[j]) * siluf_(bf2f(zp[0]));
          Y1[i] = (Y1[i] + dsk * xs1[j]) * siluf_(bf2f(zp[32]));
        }
      }
#pragma unroll
      for (int i = 0; i < 16; ++i) {
        float s_ = Y0[i] * Y0[i] + Y1[i] * Y1[i];
        s_ += shx(s_, 1); s_ += shx(s_, 2); s_ += shx(s_, 4); s_ += shx(s_, 8); s_ += shx(s_, 16);
        if (l32 == 0) ssq[wave * 32 + crow(i, half)] = s_;
      }
      __syncthreads();
#pragma unroll
      for (int i = 0; i < 16; ++i) {
        const int rr = crow(i, half), t = tt * 32 + rr;
        const float tot = ssq[rr] + ssq[32 + rr] + ssq[64 + rr] + ssq[96 + rr];
        const float rs = rsqrtf(tot * (1.f / 256.f) + EPS);
        bfr* mp = mix + (tg0 + t) * DM + head * 64;
        mp[l32] = f2bf(Y0[i] * rs * g0);
        mp[32 + l32] = f2bf(Y1[i] * rs * g1);
      }
      __syncthreads();
    }
  }
}

struct AttnSt { float m, l; f32x4 o[4]; };
DI void attn_init(AttnSt& s, float m0, float l0) {
  s.m = m0; s.l = l0;
#pragma unroll
  for (int i = 0; i < 4; ++i) s.o[i] = (f32x4){0.f, 0.f, 0.f, 0.f};
}
DI void attn_scores(const bfr* Kp, int key0, const bf16x8& q0, const bf16x8& q1, int r, int quad, float* sc) {
  const bfr* kr = Kp + (size_t)key0 * 64 + (quad * 16 + r) * 8;
  const bf16x8 a00 = ld8(kr), a01 = ld8(kr + 512), a10 = ld8(kr + 1024), a11 = ld8(kr + 1536);
  f32x4 s0 = {0.f, 0.f, 0.f, 0.f}, s1 = {0.f, 0.f, 0.f, 0.f};
  s0 = MFMA16(a00, q0, s0); s0 = MFMA16(a01, q1, s0);
  s1 = MFMA16(a10, q0, s1); s1 = MFMA16(a11, q1, s1);
#pragma unroll
  for (int i = 0; i < 4; ++i) { sc[i] = s0[i]; sc[4 + i] = s1[i]; }
}
DI void attn_pv(AttnSt& s, const bfr* VTp, int key0, const bf16x8& pb, int r, int quad) {
  const bfr* vb = VTp + (size_t)key0 * 64 + (quad * 16 + r) * 8;
#pragma unroll
  for (int dt = 0; dt < 4; ++dt) s.o[dt] = MFMA16(ld8(vb + dt * 512), pb, s.o[dt]);
}
DI float attn_finish_l(const AttnSt& s) { float l = swadd16(s.l); l = swadd32(l); return l; }
DI void load_q(const bfr* qn, size_t t0, int hbase, int lane, bf16x8& q0, bf16x8& q1) {
  const int r = lane & 15, quad = lane >> 4;
  const bfr* qp = qn + (t0 + (r >> 2)) * 512 + (hbase + (r & 3)) * 64 + quad * 8;
  q0 = ld8(qp); q1 = ld8(qp + 32);
}

struct KV32 { bf16x8 k[4]; bf16x8 v[4]; };
struct UnitD { const bfr* Kp; const bfr* VTp; int key0, hi, lo; bool fast, colok; };
DI void load_kv32(KV32& r, const UnitD& d, int rr, int quad) {
  const size_t off = (size_t)d.key0 * 64 + (quad * 16 + rr) * 8;
  const bfr* kr = d.Kp + off;
  const bfr* vb = d.VTp + off;
#pragma unroll
  for (int i = 0; i < 4; ++i) { r.k[i] = ld8(kr + i * 512); r.v[i] = ld8(vb + i * 512); }
}
template <int MODE>
DI void attn_step32(AttnSt& s, const KV32& kv, const bf16x8& q0, const bf16x8& q1, const UnitD& d, int quad) {
  f32x4 s0 = {0.f, 0.f, 0.f, 0.f}, s1 = {0.f, 0.f, 0.f, 0.f};
  s0 = MFMA16(kv.k[0], q0, s0); s0 = MFMA16(kv.k[1], q1, s0);
  s1 = MFMA16(kv.k[2], q0, s1); s1 = MFMA16(kv.k[3], q1, s1);
  float sc[8];
  float lm = -3e38f;
#pragma unroll
  for (int i = 0; i < 8; ++i) {
    float v = (i < 4 ? s0[i & 3] : s1[i & 3]);
    if (MODE == 0) { const int key = d.key0 + (i >> 2) * 16 + quad * 4 + (i & 3); v = (key <= d.hi && key >= d.lo) ? v : -3e38f; }
    sc[i] = v; lm = fmaxf(lm, v);
  }
  if (MODE == 1) lm = d.colok ? lm : -3e38f;
  if (__builtin_amdgcn_ballot_w64(lm > s.m + 8.f) != 0ull) {
    float mt = swmax16(lm); mt = swmax32(mt);
    const float mn = fmaxf(s.m, mt);
    const float alpha = ex2(s.m - mn);
    s.l *= alpha; s.m = mn;
#pragma unroll
    for (int dt = 0; dt < 4; ++dt) s.o[dt] *= alpha;
  }
  const float meff = (MODE == 1) ? (d.colok ? s.m : 1e30f) : s.m;
  float ps = 0.f;
#pragma unroll
  for (int i = 0; i < 8; ++i) { sc[i] = ex2(sc[i] - meff); ps += sc[i]; }
  s.l += ps;
  const bf16x8 pb = pack8(sc[0], sc[1], sc[2], sc[3], sc[4], sc[5], sc[6], sc[7]);
#pragma unroll
  for (int dt = 0; dt < 4; ++dt) s.o[dt] = MFMA16(kv.v[dt], pb, s.o[dt]);
}
#define PIN_LOADS() do { asm volatile("" ::: "memory"); __builtin_amdgcn_sched_barrier(0); } while (0)
template <class UF>
DI void attn_stream(AttnSt& s, int n, const UF& uf, const bf16x8& q0, const bf16x8& q1, int lane) {
  const int rr = lane & 15, quad = lane >> 4;
  if (n <= 0) return;
  KV32 a, b;
  { const UnitD d = uf(0); load_kv32(a, d, rr, quad); }
  PIN_LOADS();
#pragma unroll 1
  for (int u = 0; u < n; u += 2) {
    { const UnitD dn = uf(u + 1 < n ? u + 1 : n - 1); load_kv32(b, dn, rr, quad); }
    PIN_LOADS();
    { const UnitD d = uf(u); if (d.fast) attn_step32<1>(s, a, q0, q1, d, quad); else attn_step32<0>(s, a, q0, q1, d, quad); }
    PIN_LOADS();
    { const UnitD dn = uf(u + 2 < n ? u + 2 : n - 1); load_kv32(a, dn, rr, quad); }
    PIN_LOADS();
    if (u + 1 < n) { const UnitD d = uf(u + 1); if (d.fast) attn_step32<1>(s, b, q0, q1, d, quad); else attn_step32<0>(s, b, q0, q1, d, quad); }
    PIN_LOADS();
  }
}

DI void swa_item(const Params& p, int oi, int witem) {
  unsigned char* ws = p.ws;
  const bfr* qn = (const bfr*)(ws + OFF_S + 96 * MBy);
  const bfr* ksw = (const bfr*)(ws + OFF_S + 128 * MBy);
  const bfr* vswT = (const bfr*)(ws + OFF_S + 136 * MBy);
  bfr* mix = (bfr*)(ws + OFF_MIX);
  const int lane = otid() & 63, r = lane & 15, quad = lane >> 4;
  const int bg = witem >> 12, qd = witem & 4095, b = bg >> 1, g = bg & 1, t0 = qd * 4;
  bf16x8 q0, q1;
  load_q(qn, (size_t)b * L + t0, g * 4, lane, q0, q1);
  const int tq = t0 + (r >> 2), lo = tq - 127 > 0 ? tq - 127 : 0;
  const float sink = p.in[21][oi * 8 + g * 4 + (r & 3)];
  AttnSt s;
  attn_init(s, sink * LOG2E, quad == 0 ? 1.f : 0.f);
  const bfr* Kp = ksw + (size_t)bg * L * 64;
  const bfr* VTp = vswT + (size_t)bg * 256 * 4096;
  {
    int ks = t0 - 127; ks = ks < 0 ? 0 : (ks & ~31);
    const int n = ((t0 + 3) >> 5) - (ks >> 5) + 1;
    const int lomax = t0 + 3 - 127;
    auto uf = [&](int u) { UnitD d; d.Kp = Kp; d.VTp = VTp; d.key0 = ks + 32 * u; d.hi = tq; d.lo = lo; d.fast = (d.key0 >= lomax) && (d.key0 + 31 <= t0); d.colok = true; return d; };
    attn_stream(s, n, uf, q0, q1, lane);
  }
  const float l = attn_finish_l(s), inv = 1.f / l;
  bfr* mp = mix + ((size_t)b * L + tq) * DM + (g * 4 + (r & 3)) * 64 + quad * 4;
#pragma unroll
  for (int dt = 0; dt < 4; ++dt) {
    u32x2 o = {pk2(s.o[dt][0] * inv, s.o[dt][1] * inv), pk2(s.o[dt][2] * inv, s.o[dt][3] * inv)};
    *(u32x2*)(mp + dt * 16) = o;
  }
}

DI void nsa_item(const Params& p, int witem, float* wl) {
  unsigned char* ws = p.ws;
  const bfr* qn = (const bfr*)(ws + OFF_S + 96 * MBy);
  const bfr* parts = (const bfr*)(ws + OFF_S + 128 * MBy);
  const bfr* kc = (const bfr*)(ws + OFF_KC);
  const bfr* vcT = (const bfr*)(ws + OFF_VCT);
  const float* gates = (const float*)(ws + OFF_GATES);
  bfr* mix = (bfr*)(ws + OFF_MIX);
  float* own4 = wl; float* lastp = wl + 1024; int* sel = (int*)(wl + 2048);
  const int lane = otid() & 63, r = lane & 15, quad = lane >> 4;
  const int bg = witem >> 12, qd = witem & 4095, b = bg >> 1, g = bg & 1, t0 = qd * 4;
  bf16x8 q0, q1;
  load_q(qn, (size_t)b * L + t0, g * 4, lane, q0, q1);
  const int tok = r >> 2, tq = t0 + tok;
  float* resl = wl + 2176;
  const float* gp = gates + ((size_t)b * L + tq) * 24 + g * 12 + (r & 3) * 3;
  const float g_cmp = gp[0], g_slc = gp[1], g_win = gp[2];
  for (int rp = 0; rp < ((NSAREP & 1) ? 2 : 1); ++rp) {
    const bfr* Kp = kc + (size_t)bg * 1024 * 64;
    const bfr* VTp = vcT + (size_t)bg * 16 * 4096;
    const int hi = tq >= 31 ? ((tq - 31) >> 4) : -1;
    const int tmax = t0 + 3, nmax = tmax >= 31 ? ((tmax - 31) >> 4) : -1;
    float m = NEGF, lsum = 0.f;
    for (int k0 = 0; k0 <= nmax; k0 += 32) {
      float sc[8];
      attn_scores(Kp, k0, q0, q1, r, quad, sc);
      float mt = NEGF;
#pragma unroll
      for (int i = 0; i < 8; ++i) { const int key = k0 + (i >> 2) * 16 + quad * 4 + (i & 3); sc[i] = key <= hi ? sc[i] : NEGF; mt = fmaxf(mt, sc[i]); }
      mt = swmax16(mt); mt = swmax32(mt);
      const float mn = fmaxf(m, mt);
      float ps = 0.f;
#pragma unroll
      for (int i = 0; i < 8; ++i) { const int key = k0 + (i >> 2) * 16 + quad * 4 + (i & 3); ps += key <= hi ? ex2(sc[i] - mn) : 0.f; }
      lsum = lsum * ex2(m - mn) + ps; m = mn;
    }
    lsum = swadd16(lsum); lsum = swadd32(lsum);
    const float inv = lsum > 0.f ? 1.f / lsum : 0.f;
    AttnSt s; attn_init(s, m, 0.f);
    for (int k0 = 0; k0 <= nmax; k0 += 32) {
      float sc[8];
      attn_scores(Kp, k0, q0, q1, r, quad, sc);
#pragma unroll
      for (int i = 0; i < 8; ++i) { const int key = k0 + (i >> 2) * 16 + quad * 4 + (i & 3); sc[i] = key <= hi ? ex2(sc[i] - m) * inv : 0.f; }
      const bf16x8 pb = pack8(sc[0], sc[1], sc[2], sc[3], sc[4], sc[5], sc[6], sc[7]);
      attn_pv(s, VTp, k0, pb, r, quad);
#pragma unroll
      for (int i = 0; i < 8; ++i) { sc[i] += xor1(sc[i]); sc[i] += xor2(sc[i]); }
      if ((r & 3) == 0) {
        const int j0 = (k0 >> 2) + quad;
        own4[tok * 256 + j0] = sc[0] + sc[1] + sc[2] + sc[3]; lastp[tok * 256 + j0] = sc[3];
        own4[tok * 256 + j0 + 4] = sc[4] + sc[5] + sc[6] + sc[7]; lastp[tok * 256 + j0 + 4] = sc[7];
      }
    }
#pragma unroll
    for (int dt = 0; dt < 4; ++dt)
#pragma unroll
      for (int i = 0; i < 4; ++i) resl[(dt * 4 + i) * 64 + lane] = s.o[dt][i] * g_cmp;
  }
  __builtin_amdgcn_wave_barrier();
  __builtin_amdgcn_s_waitcnt(0xc07f);
  for (int rp = 0; rp < ((NSAREP & 2) ? 2 : 1); ++rp) {
    const int cur = t0 >> 6;
    if (cur < 16) {
      sel[lane] = (lane & 15) + 1;
    } else {
#pragma unroll 1
      for (int tk = 0; tk < 4; ++tk) {
        unsigned u[4];
#pragma unroll
        for (int c = 0; c < 4; ++c) {
          const int j = lane + 64 * c;
          const bool forced = (j == 0) || (j == cur) || (j == cur - 1);
          float v = -1e9f;
          if (j <= cur) { v = own4[tk * 256 + j]; if (j > 0) v += lastp[tk * 256 + j - 1]; }
          const unsigned bb = __float_as_uint(v);
          u[c] = forced ? 0u : ((bb & 0x80000000u) ? ~bb : (bb | 0x80000000u));
        }
        unsigned prefix = 0u;
#pragma unroll 1
        for (int bit = 31; bit >= 0; --bit) {
          const unsigned trial = prefix | (1u << bit);
          int cnt = 0;
#pragma unroll
          for (int c = 0; c < 4; ++c) cnt += __builtin_popcountll(__builtin_amdgcn_ballot_w64(u[c] >= trial));
          if (cnt >= 13) prefix = trial;
        }
        int ngt = 0;
        unsigned long long mgt[4], meq[4];
#pragma unroll
        for (int c = 0; c < 4; ++c) { mgt[c] = __builtin_amdgcn_ballot_w64(u[c] > prefix); meq[c] = __builtin_amdgcn_ballot_w64(u[c] == prefix); ngt += __builtin_popcountll(mgt[c]); }
        const int need = 13 - ngt;
        int eqbase = 0, pos = 0;
#pragma unroll
        for (int c = 0; c < 4; ++c) {
          const int below_eq = __builtin_amdgcn_mbcnt_hi((unsigned)(meq[c] >> 32), __builtin_amdgcn_mbcnt_lo((unsigned)meq[c], 0u));
          const bool take = (u[c] > prefix) || ((u[c] == prefix) && (eqbase + below_eq < need));
          const unsigned long long mt = __builtin_amdgcn_ballot_w64(take);
          const int below = __builtin_amdgcn_mbcnt_hi((unsigned)(mt >> 32), __builtin_amdgcn_mbcnt_lo((unsigned)mt, 0u));
          if (take) sel[tk * 16 + pos + below] = lane + 64 * c;
          pos += __builtin_popcountll(mt);
          eqbase += __builtin_popcountll(meq[c]);
        }
      }
    }
  }
  __builtin_amdgcn_wave_barrier();
  __builtin_amdgcn_s_waitcnt(0xc07f);
  for (int rp = 0; rp < ((NSAREP & 4) ? 2 : 1); ++rp) {
    const bfr* Kp = parts + (size_t)2 * (4u * MBy) + (size_t)bg * L * 64;
    const bfr* VTp = parts + (size_t)3 * (4u * MBy) + (size_t)bg * 256 * 4096;
    AttnSt s; attn_init(s, NEGF, 0.f);
    {
      const int selv = sel[lane];
      const int cur = t0 >> 6;
      const int nnf = cur >= 16 ? 13 : (cur >= 2 ? cur - 2 : 0);
      const int nf = cur >= 2 ? 3 : cur + 1;
      auto uf = [&](int u) {
        UnitD d; d.Kp = Kp; d.VTp = VTp; d.lo = 0;
        if (u < 2 * nf) {
          const int fi = u >> 1, j = (fi == 0) ? 0 : (nf == 2 ? 1 : (fi == 1 ? cur - 1 : cur));
          d.key0 = j * 64 + (u & 1) * 32; d.colok = true; d.hi = tq; d.fast = j < cur;
        } else {
          const int v = u - 2 * nf, tk = v / (2 * nnf), rem = v - tk * 2 * nnf, k = rem >> 1;
          const int j = __builtin_amdgcn_readlane(selv, tk * 16 + k);
          d.key0 = j * 64 + (rem & 1) * 32; d.colok = (tok == tk); d.hi = d.colok ? t0 + tk : -1; d.fast = true;
        }
        return d; };
      attn_stream(s, 2 * nf + 8 * nnf, uf, q0, q1, lane);
    }
    const float l = attn_finish_l(s), inv = (l > 0.f ? g_slc / l : 0.f) * (rp == 0 ? 1.f : 1e-30f);
#pragma unroll
    for (int dt = 0; dt < 4; ++dt)
#pragma unroll
      for (int i = 0; i < 4; ++i) resl[(dt * 4 + i) * 64 + lane] += s.o[dt][i] * inv;
  }
  {
    const bfr* Kp = parts + (size_t)4 * (4u * MBy) + (size_t)bg * L * 64;
    const bfr* VTp = parts + (size_t)5 * (4u * MBy) + (size_t)bg * 256 * 4096;
    AttnSt s; attn_init(s, NEGF, 0.f);
    const int lo = tq - 511 > 0 ? tq - 511 : 0;
    int ks = t0 - 511; ks = ks < 0 ? 0 : (ks & ~31);
    const int n = ((t0 + 3) >> 5) - (ks >> 5) + 1;
    const int lomax = t0 + 3 - 511;
    auto uf = [&](int u) { UnitD d; d.Kp = Kp; d.VTp = VTp; d.key0 = ks + 32 * u; d.hi = tq; d.lo = lo; d.fast = (d.key0 >= lomax) && (d.key0 + 31 <= t0); d.colok = true; return d; };
    attn_stream(s, n, uf, q0, q1, lane);
    const float l = attn_finish_l(s), inv = l > 0.f ? g_win / l : 0.f;
#pragma unroll
    for (int dt = 0; dt < 4; ++dt) {
      f32x4 r4;
#pragma unroll
      for (int i = 0; i < 4; ++i) r4[i] = resl[(dt * 4 + i) * 64 + lane] + s.o[dt][i] * inv;
      s.o[dt] = r4;
    }
    bfr* mp = mix + ((size_t)b * L + tq) * DM + 512 + (g * 4 + (r & 3)) * 64 + quad * 4;
#pragma unroll
    for (int dt = 0; dt < 4; ++dt) *(u32x2*)(mp + dt * 16) = pk4(s.o[dt]);
  }
  __builtin_amdgcn_wave_barrier();
}

template <bool PASSB>
DI void s5_item(const Params& p, int oi, int witem, float* wl  ) {
  unsigned char* ws = p.ws;
  const float* us5 = (const float*)(ws + OFF_S);
  bfr* yg = (bfr*)(ws + OFF_S + 64 * MBy);
  float* S = (float*)(ws + OFF_S5S);
  const float* pre = (const float*)(ws + OFF_S5PRE) + (size_t)oi * 131072;
  const int lane = otid() & 63;
  const int bgi = witem >> 8, c = witem & 255, b = bgi >> 5, g = bgi & 31;
  const int gp = g * 64 + lane;
  const float lre = pre[gp * 2], lim = pre[gp * 2 + 1];
  float bre[16], bim[16];
#pragma unroll
  for (int h = 0; h < 16; ++h) { bre[h] = pre[8192 + gp * 32 + h]; bim[h] = pre[8192 + gp * 32 + 16 + h]; }
  const size_t tg0 = (size_t)b * L + c * 64;
  __builtin_amdgcn_wave_barrier();
#pragma unroll
  for (int i = 0; i < 4; ++i) {
    const int idx = i * 64 + lane, tt = idx >> 2, q = idx & 3;
    *(f32x4*)(wl + tt * 16 + q * 4) = *(const f32x4*)(us5 + (tg0 + tt) * 512 + g * 16 + q * 4);
  }
  __builtin_amdgcn_wave_barrier();
  __builtin_amdgcn_s_waitcnt(0xc07f);
  float xre = 0.f, xim = 0.f;
  if (PASSB) {
    const float Lre = pre[4096 + gp * 2], Lim = pre[4096 + gp * 2 + 1];
    const float* Sp = S + (size_t)bgi * 256 * 128;
    int cc = 0;
    for (; cc + 8 <= c; cc += 8) {
      float sr[8], si[8];
#pragma unroll
      for (int k = 0; k < 8; ++k) { sr[k] = Sp[(cc + k) * 128 + lane]; si[k] = Sp[(cc + k) * 128 + 64 + lane]; }
      asm volatile("" ::: "memory"); __builtin_amdgcn_sched_barrier(0);
#pragma unroll
      for (int k = 0; k < 8; ++k) { const float nr = Lre * xre - Lim * xim + sr[k], ni = Lre * xim + Lim * xre + si[k]; xre = nr; xim = ni; }
    }
    for (; cc < c; ++cc) {
      const float sr = Sp[cc * 128 + lane], si = Sp[cc * 128 + 64 + lane];
      const float nr = Lre * xre - Lim * xim + sr, ni = Lre * xim + Lim * xre + si;
      xre = nr; xim = ni;
    }
  }
  const int r16 = lane & 15, quad = lane >> 4;
  bf16x8 cf[4];
  f32x4 dsk4 = {0.f, 0.f, 0.f, 0.f};
  bfr* xl = (bfr*)(wl + 1024);
  if (PASSB) {
    const float* cr = p.in[27] + ((size_t)oi * 32 + g) * 16 * 64 + r16 * 64;
    const float* ci = p.in[28] + ((size_t)oi * 32 + g) * 16 * 64 + r16 * 64;
#pragma unroll
    for (int ks = 0; ks < 4; ++ks) {
      const float* src = (ks < 2 ? cr : ci) + (ks & 1) * 32 + quad * 8;
      const f32x4 a0 = *(const f32x4*)src, a1 = *(const f32x4*)(src + 4);
      const float sg = ks < 2 ? 1.f : -1.f;
      cf[ks] = pack8(sg * a0[0], sg * a0[1], sg * a0[2], sg * a0[3], sg * a1[0], sg * a1[1], sg * a1[2], sg * a1[3]);
    }
    dsk4 = *(const f32x4*)(p.in[29] + (size_t)oi * 512 + g * 16 + quad * 4);
  }
#pragma unroll 1
  for (int tb = 0; tb < 4; ++tb) {
#pragma unroll 2
    for (int t16 = 0; t16 < 16; ++t16) {
      const int tt = tb * 16 + t16;
      float u[16];
#pragma unroll
      for (int q = 0; q < 4; ++q) { const f32x4 v = *(const f32x4*)(wl + tt * 16 + q * 4); u[q * 4] = v[0]; u[q * 4 + 1] = v[1]; u[q * 4 + 2] = v[2]; u[q * 4 + 3] = v[3]; }
      float ar0 = 0.f, ar1 = 0.f, ai0 = 0.f, ai1 = 0.f;
#pragma unroll
      for (int h = 0; h < 16; h += 2) { ar0 += bre[h] * u[h]; ar1 += bre[h + 1] * u[h + 1]; ai0 += bim[h] * u[h]; ai1 += bim[h + 1] * u[h + 1]; }
      const float ar = ar0 + ar1, ai = ai0 + ai1;
      const float nr = lre * xre - lim * xim + ar, ni = lre * xim + lim * xre + ai;
      xre = nr; xim = ni;
      if (PASSB) { xl[t16 * 136 + lane] = f2bf(xre); xl[t16 * 136 + 64 + lane] = f2bf(xim); }
    }
    if (PASSB) {
      __builtin_amdgcn_wave_barrier();
      f32x4 y = {0.f, 0.f, 0.f, 0.f};
#pragma unroll
      for (int ks = 0; ks < 4; ++ks) y = MFMA16(cf[ks], *(const bf16x8*)(xl + r16 * 136 + ks * 32 + quad * 8), y);
      const int t = tb * 16 + r16;
      const f32x4 uu = *(const f32x4*)(wl + t * 16 + quad * 4);
      f32x4 o;
#pragma unroll
      for (int i = 0; i < 4; ++i) o[i] = gelu_tanh(y[i] + dsk4[i] * uu[i]);
      *(u32x2*)(yg + (tg0 + t) * 512 + g * 16 + quad * 4) = pk4(o);
      __builtin_amdgcn_wave_barrier();
    }
  }
  if (!PASSB) {
    float* Sp = S + ((size_t)bgi * 256 + c) * 128;
    Sp[lane] = xre; Sp[64 + lane] = xim;
  }
  __builtin_amdgcn_wave_barrier();
}

__global__ void __launch_bounds__(256, 2) fwd_mega(Params p) {
  __shared__ __attribute__((aligned(16))) unsigned char smem[56832];
  cg::grid_group grid = cg::this_grid();
  unsigned char* ws = p.ws;
  const int tid = threadIdx.x, wave = __builtin_amdgcn_readfirstlane(tid >> 6);
  float* rowss = (float*)(ws + OFF_ROWSS);
  bfr* hb = (bfr*)(ws + OFF_HB);
  bfr* mixb = (bfr*)(ws + OFF_MIX);
  __shared__ __attribute__((aligned(16))) unsigned xbw[4];
  __shared__ int xmw[4];
  if (tid == 0) { xbw[0] = 0u; xbw[1] = 0u; xbw[2] = 0u; xbw[3] = 0u; }
  __syncthreads();
  XcdBarrier xb; xb.bar = (unsigned*)(ws + OFF_BAR); xb.x = xb_xcc_id(); xb.st = (volatile LAS unsigned*)xbw;
  unsigned myloc = 0;
  if (tid == 0) myloc = xb_add(&xb.bar[XB_XCNT(xb.x)], 1u);
  for (int rep = 0; rep < (((REPMASK >> 15) & 1) ? 2 : 1); ++rep) {
  if (PHMASK & 1) prep_phase(p, smem);
  if (p.njobs < 0) grid.sync();
  xcd_barrier(xb);
  }
  if (tid == 0) {
    unsigned cnt[8], sum = 0, okf = 1;
    for (int j = 0; j < 8; ++j) { cnt[j] = xb_ld(&xb.bar[XB_XCNT(j)]); sum += cnt[j]; okf &= (cnt[j] > 0u) ? 1u : 0u; }
    okf &= (sum == gridDim.x) ? 1u : 0u; okf &= (xb.x < 8u) ? 1u : 0u;
    xmw[0] = (int)okf; xmw[1] = (int)xb.x; xmw[2] = (int)myloc; xmw[3] = (int)(xb.x < 8u ? cnt[xb.x] : 1u);
  }
  __syncthreads();
  XMap xm; xm.ok = xmw[0]; xm.xcd = xmw[1]; xm.loc = xmw[2]; xm.nloc = xmw[3];
  if (blockIdx.x == 0) {
    float* be = (float*)(ws + OFF_B1EFF);
    for (int o = tid; o < 1024; o += 256) { float sm = p.in[16][o]; for (int sl = 0; sl < 16; ++sl) sm += be[1024 + sl * 1024 + o]; be[o] = sm; }
  }
#pragma unroll 1
  for (int layer = 0; layer < 4; ++layer) {
    const int li = layer >> 1;
    const bool even = (layer & 1) == 0;
    const float* hin = layer == 0 ? p.in[0] : p.out;
    const int nst = even ? 8 : 7;
#pragma unroll 1
    for (int step = 0; step < nst; ++step) {
      GemmDesc d;
      d.kind = -1; d.rpart = nullptr; d.sA = 0; d.sB = 0; d.nbatch = 1;
      const int gk = even ? step : (step == 0 ? 8 : (step < 3 ? 8 + step : step + 1 + 6));
      const int code = even ? step : (step <= 2 ? 8 + step : (step == 3 ? 11 : (step == 4 ? 5 : step + 1)));
      (void)gk;
      const int nrep = ((REPMASK >> code) & 1) ? 2 : 1;
      for (int rep = 0; rep < nrep; ++rep) {
      switch (code) {
        case 0: {
          d.kind = 0; d.A = hb; d.lda = DM; d.Bt = (const bfr*)(ws + OFF_EVIN) + (size_t)li * EVIN_NP * 1024; d.ldb = 1024; d.M = T; d.N = EVIN_NP; d.K = 1024; d.rpart = rowss;
          d.e0 = EpiEvenIn{ws};
        } break;
        case 1: {
          if (PHMASK & 2) ssd_conv_phase(p, li, smem);
          d.kind = 5; d.A = (const bfr*)(ws + OFF_S + 128 * MBy); d.lda = 1024; d.sA = (size_t)4096 * 1024; d.Bt = (const bfr*)(ws + OFF_W1) + (size_t)li * 2 * 256 * 2048; d.ldb = 2048;
          d.sB = (size_t)256 * 2048; d.M = 4096; d.N = 256; d.K = 2048; d.nbatch = 2;
          d.e5 = EpiW1{ws, li};
        } break;
        case 2: {
          if (PHMASK & 4) for (int it = blockIdx.x; it < 512; it += gridDim.x) ssd_states_item(p, it * 4 + wave, (float*)smem + wave * 128);
          d.kind = 6; d.A = (const bfr*)(ws + OFF_NSAHID); d.lda = 256; d.sA = (size_t)4096 * 256; d.Bt = (const bfr*)(ws + OFF_W2) + (size_t)li * 2 * 128 * 256; d.ldb = 256;
          d.sB = (size_t)128 * 256; d.M = 4096; d.N = 128; d.K = 256; d.nbatch = 2;
          d.e6 = EpiW2{ws, p.in[18] + li * 128};
        } break;
        case 3: {
          if (rep == 0) for (int it = blockIdx.x; it < 512; it += gridDim.x) { if (PHMASK & 8) ssd_carry_item(p, it); }
          if (xm.ok) {
            const int bg = xm.xcd >> 1, sub = xm.xcd & 1;
            for (int k = xm.loc; k < 512; k += xm.nloc) { if (PHMASK & 16) nsa_item(p, bg * 4096 + (2 * k + sub) * 4 + wave, (float*)smem + wave * 3200); }
          } else {
            for (int it = blockIdx.x; it < 4096; it += gridDim.x) { if (PHMASK & 16) nsa_item(p, it * 4 + wave, (float*)smem + wave * 3200); }
          }
        } break;
        case 4: { if (PHMASK & 32) ssd_out_phase(p, li, smem); } break;
        case 5: {
          d.kind = 2; d.A = mixb; d.lda = DM; d.Bt = (even ? (const bfr*)(ws + OFF_EVOUT) : (const bfr*)(ws + OFF_ODOUT)) + (size_t)li * 1024 * 1024; d.ldb = 1024; d.M = T; d.N = 1024; d.K = 1024;
          d.e2 = EpiRes{hin, p.out, hb, rowss + (size_t)T * 16};
        } break;
        case 6: {
          d.kind = 3; d.A = hb; d.lda = DM; d.Bt = (const bfr*)(ws + OFF_WUP) + (size_t)layer * 4096 * 1024; d.ldb = 1024; d.M = T; d.N = 4096; d.K = 1024; d.rpart = rowss + (size_t)T * 16;
          d.e3 = EpiUp{ws};
        } break;
        case 7: {
          d.kind = 2; d.A = (const bfr*)(ws + OFF_S); d.lda = 4096; d.Bt = (const bfr*)(ws + OFF_WDN) + (size_t)layer * 1024 * 4096; d.ldb = 4096; d.M = T; d.N = 1024; d.K = 4096;
          d.e2 = EpiRes{p.out, p.out, hb, rowss};
        } break;
        case 8: {
          d.kind = 1; d.A = hb; d.lda = DM; d.Bt = (const bfr*)(ws + OFF_ODIN) + (size_t)li * 1280 * 1024; d.ldb = 1024; d.M = T; d.N = 1280; d.K = 1024; d.rpart = rowss;
          d.e1 = EpiOddIn{ws};
        } break;
        case 9: {
          for (int it = blockIdx.x; it < 4096; it += gridDim.x) { if (PHMASK & 64) s5_item<false>(p, li, it * 4 + wave, (float*)smem + wave * 2176); }
          if (xm.ok) {
            const int bg = xm.xcd >> 1, sub = xm.xcd & 1;
            for (int k = xm.loc; k < 512; k += xm.nloc) { if (PHMASK & 128) swa_item(p, li, bg * 4096 + (2 * k + sub) * 4 + wave); }
          } else {
            for (int it = blockIdx.x; it < 4096; it += gridDim.x) { if (PHMASK & 128) swa_item(p, li, it * 4 + wave); }
          }
        } break;
        case 10: { if (PHMASK & 256) for (int it = blockIdx.x; it < 4096; it += gridDim.x) s5_item<true>(p, li, it * 4 + wave, (float*)smem + wave * 2176); } break;
        default: {
          d.kind = 4; d.A = (const bfr*)(ws + OFF_S + 64 * MBy); d.lda = 512; d.Bt = (const bfr*)(ws + OFF_GLU) + (size_t)li * 512 * 512; d.ldb = 512; d.M = T; d.N = 512; d.K = 512;
          d.e4 = EpiGlu{ws, p.in[31] + li * 512};
        } break;
      }
      if ((PHMASK & 512) && d.kind >= 0) gemm_phase_(d, smem, xm);
      xcd_barrier(xb);
      }
    }
  }
  {
    const float* rs = rowss;
    const float* gf = p.in[3];
    const int lane = tid & 63;
    f32x4 gg[4];
#pragma unroll
    for (int i = 0; i < 4; ++i) gg[i] = *(const f32x4*)(gf + (i * 64 + lane) * 4);
#pragma unroll 1
    for (int row = (blockIdx.x * 4 + wave) * 2; row < T; row += gridDim.x * 8) {
      f32x4 v[2][4], pr[2][4];
#pragma unroll
      for (int rr = 0; rr < 2; ++rr) {
#pragma unroll
        for (int q = 0; q < 4; ++q) pr[rr][q] = *(const f32x4*)(rs + (size_t)(row + rr) * 16 + q * 4);
#pragma unroll
        for (int i = 0; i < 4; ++i) v[rr][i] = *(const f32x4*)(p.out + (size_t)(row + rr) * DM + (i * 64 + lane) * 4);
      }
      asm volatile("" ::: "memory"); __builtin_amdgcn_sched_barrier(0);
#pragma unroll
      for (int rr = 0; rr < 2; ++rr) {
        float sm = 0.f;
#pragma unroll
        for (int q = 0; q < 4; ++q) { sm += pr[rr][q][0]; sm += pr[rr][q][1]; sm += pr[rr][q][2]; sm += pr[rr][q][3]; }
        const float r = rsqrtf(sm * (1.f / DM) + EPS);
#pragma unroll
        for (int i = 0; i < 4; ++i) *(f32x4*)(p.out + (size_t)(row + rr) * DM + (i * 64 + lane) * 4) = v[rr][i] * gg[i] * r;
      }
    }
  }
}

extern "C" void kernel_launch(void* const* d_in, const int* in_sizes, int n_in, void* d_out, int out_size, void* d_ws, size_t ws_size, hipStream_t stream) {
  static int grid_blocks = 0;
  if (!grid_blocks) {
    int dev = 0, cus = 0, per_cu = 0;
    hipGetDevice(&dev);
    hipDeviceGetAttribute(&cus, hipDeviceAttributeMultiprocessorCount, dev);
    hipOccupancyMaxActiveBlocksPerMultiprocessor(&per_cu, fwd_mega, 256, 0);
    if (per_cu > 2) per_cu = 2;
    grid_blocks = cus * per_cu;
    if (ws_size < WS_NEED) { fprintf(stderr, "workspace too small: %zu < %zu\n", ws_size, (size_t)WS_NEED); grid_blocks = -1; }
  }
  if (grid_blocks <= 0) return;
  Params p{};
  for (int i = 0; i < 32 && i < n_in; ++i) p.in[i] = (const float*)d_in[i];
  p.out = (float*)d_out;
  p.ws = (unsigned char*)d_ws;
  unsigned char* ws = (unsigned char*)d_ws;
  int nj = 0, t0 = 0;
  auto add = [&](const float* src, size_t dstoff, const float* scale, int K, int N) {
    TJob& j = p.jobs[nj++];
    j.src = src; j.dst = (bfr*)(ws + dstoff); j.scale = scale; j.K = K; j.N = N; j.tile0 = t0; j.pad = 0;
    t0 += (K / 64) * (N / 32);
  };
  const float* const* in = (const float* const*)d_in;
  for (int l = 0; l < 4; ++l) {
    add(in[4] + (size_t)l * 1024 * 4096, OFF_WUP + (size_t)l * 4096 * 1024 * 2, in[2] + l * 1024, 1024, 4096);
    add(in[5] + (size_t)l * 4096 * 1024, OFF_WDN + (size_t)l * 1024 * 4096 * 2, nullptr, 4096, 1024);
  }
  for (int i = 0; i < 2; ++i) {
    add(in[6] + (size_t)i * 1024 * EVIN_N, OFF_EVIN + (size_t)i * EVIN_NP * 1024 * 2, in[1] + (2 * i) * 1024, 1024, EVIN_N);
    add(in[7] + (size_t)i * 1024 * 1024, OFF_EVOUT + (size_t)i * 1024 * 1024 * 2, nullptr, 1024, 1024);
    add(in[19] + (size_t)i * 1024 * 1280, OFF_ODIN + (size_t)i * 1280 * 1024 * 2, in[1] + (2 * i + 1) * 1024, 1024, 1280);
    add(in[20] + (size_t)i * 1024 * 1024, OFF_ODOUT + (size_t)i * 1024 * 1024 * 2, nullptr, 1024, 1024);
    add(in[30] + (size_t)i * 512 * 512, OFF_GLU + (size_t)i * 512 * 512 * 2, nullptr, 512, 512);
    for (int kv = 0; kv < 2; ++kv) {
      add(in[15] + (size_t)(i * 2 + kv) * 2048 * 256, OFF_W1 + (size_t)(i * 2 + kv) * 256 * 2048 * 2, nullptr, 2048, 256);
      add(in[17] + (size_t)(i * 2 + kv) * 256 * 64, OFF_W2 + (size_t)(i * 2 + kv) * 128 * 256 * 2, nullptr, 256, 64);
    }
  }
  p.njobs = nj; p.ntile_total = t0;
  hipMemsetAsync((unsigned char*)d_ws + OFF_BAR, 0, 16384, stream);
  void* args[] = {&p};
  hipError_t e = hipLaunchCooperativeKernel((void*)fwd_mega, dim3(grid_blocks), dim3(256), args, 0, stream);
  if (e != hipSuccess) fprintf(stderr, "cooperative launch failed: %s (grid %d)\n", hipGetErrorString(e), grid_blocks);
}
```
